# Optimizing an MI355X kernel written in HIP

```python
import math
import jax, jax.numpy as jnp
from jax import lax
import numpy as np

D_MODEL = 1024
BATCH = 8
SEQ = 8192
DEPTH = 2
DEC_BATCH = 8
DEC_SEQ = 2048
PAST_LEN = 128

HEAD_DIM = 64
A_HEADS = 4
A_VDIM = 2 * HEAD_DIM
B_HEADS = 4
C_HEADS = 4
MEM_TOKENS = 256
GRID_W = 64
NA_ROWS = 8
NA_COLS = 16
T5_BUCKETS = 32
T5_MAX_DIST = 128
Q_BLOCK = 128
D_FF = 2816
CONV_WIDTH = 3
EPS = 1e-6

A_QK = A_HEADS * HEAD_DIM
A_V = A_HEADS * A_VDIM
B_W = B_HEADS * HEAD_DIM
C_W = C_HEADS * HEAD_DIM
MIX_WIDTH = A_V + B_W + C_W
IN_SPLITS = (A_QK, A_QK, A_QK, A_QK, A_V, B_W, B_W, B_W, C_W)
IN_WIDTH = 4 * A_QK + A_V + 3 * B_W + C_W

kernel_name = 'hymba_diff_natten_mem_encoder'


def rms_norm(x, g):
    xf = x.astype(jnp.float32)
    y = xf * lax.rsqrt(jnp.mean(xf * xf, axis=-1, keepdims=True) + EPS)
    return (y * g.astype(jnp.float32)).astype(x.dtype)


def t5_bucket(rp):
    half = T5_BUCKETS // 2
    max_exact = half // 2
    ret = jnp.where(rp > 0, half, 0)
    n = jnp.abs(rp)
    nf = jnp.maximum(n, 1).astype(jnp.float32)
    large = max_exact + (jnp.log(nf / max_exact) / math.log(T5_MAX_DIST / max_exact)
                         * (half - max_exact)).astype(jnp.int32)
    large = jnp.minimum(large, half - 1)
    return ret + jnp.where(n < max_exact, n, large)


def diff_attention(q1, q2, k1, k2, v, rel_bias, lam, lam_init, subln_g):
    B, S, H, _ = q1.shape
    nblk = S // Q_BLOCK
    scale = HEAD_DIM ** -0.5
    keys = jnp.arange(S)

    def to_blocks(t):
        return t.reshape(B, nblk, Q_BLOCK, H, t.shape[-1]).swapaxes(0, 1)

    def block(args):
        q1b, q2b, start = args
        rp = keys[None, :] - (start + jnp.arange(Q_BLOCK))[:, None]
        bias = jnp.transpose(rel_bias[t5_bucket(rp)], (2, 0, 1)).astype(jnp.float32)
        s1 = jnp.einsum('bqhd,bkhd->bhqk', q1b, k1).astype(jnp.float32) * scale + bias
        s2 = jnp.einsum('bqhd,bkhd->bhqk', q2b, k2).astype(jnp.float32) * scale + bias
        a = jax.nn.softmax(s1, axis=-1) - lam * jax.nn.softmax(s2, axis=-1)
        return jnp.einsum('bhqk,bkhe->bqhe', a.astype(v.dtype), v)

    o = lax.map(block, (to_blocks(q1), to_blocks(q2), jnp.arange(nblk) * Q_BLOCK))
    o = o.swapaxes(0, 1).reshape(B, S, H, A_VDIM)
    return rms_norm(o, subln_g) * (1.0 - lam_init)


def neighbourhood_attention(q, k, v, bias_tab):
    B, S, H, d = q.shape
    R = S // GRID_W
    KH = min(NA_ROWS, R)
    scale = d ** -0.5
    qg = q.reshape(B, R, GRID_W, H, d)
    kg = k.reshape(B, R, GRID_W, H, d)
    vg = v.reshape(B, R, GRID_W, H, d)
    cols = jnp.arange(GRID_W)
    cs = jnp.clip(cols - NA_COLS // 2, 0, GRID_W - NA_COLS)
    colidx = cs[:, None] + jnp.arange(NA_COLS)[None, :]
    dcol = colidx - cols[:, None] + (NA_COLS - 1)

    def row(r):
        rs = jnp.clip(r - KH // 2, 0, R - KH)
        kr = lax.dynamic_slice_in_dim(kg, rs, KH, axis=1)
        vr = lax.dynamic_slice_in_dim(vg, rs, KH, axis=1)
        kw = kr[:, :, colidx]
        vw = vr[:, :, colidx]
        qr = lax.dynamic_index_in_dim(qg, r, axis=1, keepdims=False)
        s = jnp.einsum('bchd,bicjhd->bhcij', qr, kw).astype(jnp.float32) * scale
        drow = rs + jnp.arange(KH) - r + (NA_ROWS - 1)
        bias = bias_tab[:, drow[:, None, None], dcol[None, :, :]]
        s = s + jnp.transpose(bias, (0, 2, 1, 3))[None].astype(jnp.float32)
        p = jax.nn.softmax(s.reshape(B, H, GRID_W, KH * NA_COLS), axis=-1)
        p = p.reshape(B, H, GRID_W, KH, NA_COLS).astype(v.dtype)
        return jnp.einsum('bhcij,bicjhe->bche', p, vw)

    o = lax.map(row, jnp.arange(R))
    return o.swapaxes(0, 1).reshape(B, S, H, d)


def memory_attention(q, mem, mem_g, w_mem_kv, kn):
    B, M, _ = mem.shape
    kv = rms_norm(mem, mem_g) @ w_mem_kv
    k, v = jnp.split(kv, 2, axis=-1)
    k = rms_norm(k.reshape(B, M, C_HEADS, HEAD_DIM), kn)
    v = v.reshape(B, M, C_HEADS, HEAD_DIM)
    s = jnp.einsum('bqhd,bmhd->bhqm', q, k).astype(jnp.float32) * (HEAD_DIM ** -0.5)
    p = jax.nn.softmax(s, axis=-1).astype(v.dtype)
    return jnp.einsum('bhqm,bmhd->bqhd', p, v)


def dwconv_centred(h, w, b):
    S = h.shape[1]
    hp = jnp.pad(h, ((0, 0), (CONV_WIDTH // 2, CONV_WIDTH // 2), (0, 0)))
    out = b
    for i in range(CONV_WIDTH):
        out = out + w[i] * hp[:, i:i + S]
    return out


def setup_inputs(seed: int = 0) -> dict:
    key = jax.random.key(seed)
    ks = jax.random.split(key, 32)
    nrm = jax.random.normal
    f32 = jnp.float32

    def gain(k, shape):
        return 1.0 + 0.02 * nrm(k, shape, f32)

    return {
        'x_prompt': nrm(ks[0], (BATCH, SEQ, D_MODEL), f32),
        'x_sample': nrm(ks[1], (DEC_BATCH, DEC_SEQ, D_MODEL), f32),
        'mem_prompt': nrm(ks[2], (BATCH, MEM_TOKENS, D_MODEL), f32),
        'mem_sample': nrm(ks[3], (DEC_BATCH, MEM_TOKENS, D_MODEL), f32),
        'norm1_g': gain(ks[4], (DEPTH, D_MODEL)),
        'w_in': nrm(ks[5], (DEPTH, D_MODEL, IN_WIDTH), f32) * D_MODEL ** -0.5,
        'qn_a': gain(ks[6], (DEPTH, HEAD_DIM)),
        'kn_a': gain(ks[7], (DEPTH, HEAD_DIM)),
        'lam_q1': 0.1 * nrm(ks[8], (DEPTH, HEAD_DIM), f32),
        'lam_k1': 0.1 * nrm(ks[9], (DEPTH, HEAD_DIM), f32),
        'lam_q2': 0.1 * nrm(ks[10], (DEPTH, HEAD_DIM), f32),
        'lam_k2': 0.1 * nrm(ks[11], (DEPTH, HEAD_DIM), f32),
        'subln_g': gain(ks[12], (DEPTH, A_VDIM)),
        'rel_bias': 0.5 * nrm(ks[13], (T5_BUCKETS, A_HEADS), f32),
        'qn_b': gain(ks[14], (DEPTH, HEAD_DIM)),
        'kn_b': gain(ks[15], (DEPTH, HEAD_DIM)),
        'na_bias': 0.5 * nrm(ks[16], (DEPTH, B_HEADS, 2 * NA_ROWS - 1, 2 * NA_COLS - 1), f32),
        'mem_g': gain(ks[17], (DEPTH, D_MODEL)),
        'w_mem_kv': nrm(ks[18], (DEPTH, D_MODEL, 2 * C_W), f32) * D_MODEL ** -0.5,
        'qn_c': gain(ks[19], (DEPTH, HEAD_DIM)),
        'kn_c': gain(ks[20], (DEPTH, HEAD_DIM)),
        'w_out': nrm(ks[21], (DEPTH, MIX_WIDTH, D_MODEL), f32) * MIX_WIDTH ** -0.5,
        'norm2_g': gain(ks[22], (DEPTH, D_MODEL)),
        'w_up': nrm(ks[23], (DEPTH, D_MODEL, 2 * D_FF), f32) * D_MODEL ** -0.5,
        'conv_w': nrm(ks[24], (DEPTH, CONV_WIDTH, 2 * D_FF), f32) * CONV_WIDTH ** -0.5,
        'conv_b': 0.01 * nrm(ks[25], (DEPTH, 2 * D_FF), f32),
        'w_down': nrm(ks[26], (DEPTH, D_FF, D_MODEL), f32) * D_FF ** -0.5,
    }


def reference(x_prompt, x_sample, mem_prompt, mem_sample, norm1_g, w_in, qn_a, kn_a,
              lam_q1, lam_k1, lam_q2, lam_k2, subln_g, rel_bias, qn_b, kn_b, na_bias,
              mem_g, w_mem_kv, qn_c, kn_c, w_out, norm2_g, w_up, conv_w, conv_b, w_down):
    split_at = [int(i) for i in np.cumsum(IN_SPLITS)[:-1]]

    def layer(x, mem, l):
        B, S, _ = x.shape
        h = rms_norm(x, norm1_g[l])
        z = h @ w_in[l]
        q1, q2, k1, k2, va, qb, kb, vb, qc = jnp.split(z, split_at, axis=-1)
        heads = lambda t, n: t.reshape(B, S, n, t.shape[-1] // n)
        lam_init = 0.8 - 0.6 * math.exp(-0.3 * l)
        lam = (jnp.exp(jnp.sum(lam_q1[l].astype(jnp.float32) * lam_k1[l].astype(jnp.float32)))
               - jnp.exp(jnp.sum(lam_q2[l].astype(jnp.float32) * lam_k2[l].astype(jnp.float32)))
               + lam_init)
        o_a = diff_attention(rms_norm(heads(q1, A_HEADS), qn_a[l]), rms_norm(heads(q2, A_HEADS), qn_a[l]),
                             rms_norm(heads(k1, A_HEADS), kn_a[l]), rms_norm(heads(k2, A_HEADS), kn_a[l]),
                             heads(va, A_HEADS), rel_bias, lam, lam_init, subln_g[l])
        o_b = neighbourhood_attention(rms_norm(heads(qb, B_HEADS), qn_b[l]),
                                      rms_norm(heads(kb, B_HEADS), kn_b[l]),
                                      heads(vb, B_HEADS), na_bias[l])
        o_c = memory_attention(rms_norm(heads(qc, C_HEADS), qn_c[l]), mem, mem_g[l], w_mem_kv[l], kn_c[l])
        mix = jnp.concatenate([o_a.reshape(B, S, A_V), o_b.reshape(B, S, B_W),
                               o_c.reshape(B, S, C_W)], axis=-1)
        x = x + mix @ w_out[l]
        u = dwconv_centred(rms_norm(x, norm2_g[l]) @ w_up[l], conv_w[l], conv_b[l])
        val, gate = jnp.split(u, 2, axis=-1)
        return x + (jax.nn.silu(gate) * val) @ w_down[l]

    y_prompt = x_prompt
    y_sample = x_sample
    for l in range(DEPTH):
        y_prompt = layer(y_prompt, mem_prompt, l)
    for l in range(DEPTH):
        y_sample = layer(y_sample, mem_sample, l)
    return (y_prompt, y_sample)
```

```cpp
#include <hip/hip_runtime.h>
#include <hip/hip_cooperative_groups.h>
#include <hip/hip_bf16.h>
#include <cstdio>
#include <cstdint>
namespace cg = cooperative_groups;

#define LAS __attribute__((address_space(3)))
typedef unsigned short bf16_t;
typedef short bf16x8 __attribute__((ext_vector_type(8)));
typedef short s16x4 __attribute__((ext_vector_type(4)));
typedef float f32x4 __attribute__((ext_vector_type(4)));
typedef float f32x2 __attribute__((ext_vector_type(2)));
typedef float f32x16 __attribute__((ext_vector_type(16)));
typedef unsigned u32x4 __attribute__((ext_vector_type(4)));
typedef unsigned u32x2 __attribute__((ext_vector_type(2)));
typedef __bf16 bf16x2_t __attribute__((ext_vector_type(2)));

constexpr int DM = 1024, NBATCH = 8, SP = 8192, SS = 2048, MP = NBATCH * SP, MS = NBATCH * SS, MT = MP + MS;
constexpr int NZ = 2560, DFF = 2816, NUP = 2 * DFF, MEMT = 256, MMEM = 2 * NBATCH * MEMT;
constexpr int GW = 64;
constexpr float EPS = 1e-6f, LOG2E = 1.4426950408889634f, C2 = 0.125f * LOG2E;
constexpr int NTHREADS = 512;
constexpr int HT_P = 34, HT_S = 9, NHT = NBATCH * HT_P + NBATCH * HT_S;

constexpr size_t MiB = (size_t)1 << 20;
constexpr size_t WS_WL = 26 * MiB;
constexpr size_t WO_IN = 0, WO_OUT = 5 * MiB, WO_UP = 7 * MiB, WO_DN = 18 * MiB, WO_MEM = 24 * MiB;
constexpr size_t WS_GT = 52 * MiB;
constexpr size_t WS_BAR = 52 * MiB + 512 * 1024;
constexpr size_t WS_CT = 53 * MiB;
constexpr size_t WS_PS = 54 * MiB;
constexpr size_t WS_MKV = 60 * MiB;
constexpr size_t WS_XN = 65 * MiB;
constexpr size_t WS_XNM = 226 * MiB;
constexpr size_t WS_Z = 244 * MiB;
constexpr size_t WS_MIX = 644 * MiB;
constexpr size_t WS_G = WS_Z;
constexpr size_t WS_END = 804 * MiB;
static_assert(WS_G + (size_t)MT * DFF * 2 <= WS_END, "G overlay");

__device__ __forceinline__ unsigned cvtpk(float lo, float hi) { f32x2 v = {lo, hi}; bf16x2_t b = __builtin_convertvector(v, bf16x2_t); return __builtin_bit_cast(unsigned, b); }
__device__ __forceinline__ int fresh_tid(int wave) { int z = 0; asm volatile("" : "+v"(z)); return wave * 64 + (int)__builtin_amdgcn_mbcnt_hi(~0u, __builtin_amdgcn_mbcnt_lo(~0u, (unsigned)z)); }
template <int M> __device__ __forceinline__ float xor_get(float v) { return __builtin_bit_cast(float, __builtin_amdgcn_ds_swizzle(__builtin_bit_cast(int, v), 0x1F | (M << 10))); }
template <int M> __device__ __forceinline__ float bfly_add(float v) {
    if (M == 32) { auto rr = __builtin_amdgcn_permlane32_swap(__float_as_uint(v), __float_as_uint(v), false, false); return __uint_as_float(rr[0]) + __uint_as_float(rr[1]); }
    else return v + xor_get<M>(v);
}
template <int M> __device__ __forceinline__ float bfly_max(float v) {
    if (M == 32) { auto rr = __builtin_amdgcn_permlane32_swap(__float_as_uint(v), __float_as_uint(v), false, false); return fmaxf(__uint_as_float(rr[0]), __uint_as_float(rr[1])); }
    else return fmaxf(v, xor_get<M>(v));
}
__device__ __forceinline__ float wave_sum(float v) { v = bfly_add<1>(v); v = bfly_add<2>(v); v = bfly_add<4>(v); v = bfly_add<8>(v); v = bfly_add<16>(v); v = bfly_add<32>(v); return v; }
__device__ __forceinline__ float wave_max(float v) { v = bfly_max<1>(v); v = bfly_max<2>(v); v = bfly_max<4>(v); v = bfly_max<8>(v); v = bfly_max<16>(v); v = bfly_max<32>(v); return v; }
__device__ __forceinline__ float dpp_ror1(float x) { return __builtin_bit_cast(float, __builtin_amdgcn_mov_dpp(__builtin_bit_cast(int, x), 0x121, 0xF, 0xF, true)); }
__device__ __forceinline__ float dpp_ror15(float x) { return __builtin_bit_cast(float, __builtin_amdgcn_mov_dpp(__builtin_bit_cast(int, x), 0x12F, 0xF, 0xF, true)); }

namespace pg8 {
constexpr int BM = 256, BK = 64, HALF = 128, HTB = HALF * BK * 2, STAGE_BYTES = 8 * HTB, NXCD = 8, WGM = 8;
__device__ __forceinline__ int lds_byte(int r, int c) { const int st = (r >> 4) * 2 + (c >> 5), rr = r & 15, cc = c & 31, ob = rr * 64 + cc * 2; return st * 1024 + (ob ^ (((ob >> 9) & 1) << 5)); }
__device__ __forceinline__ void stage_rc(int b, int& R, int& C) { const int st = b / 1024, sb = b % 1024, swz = sb ^ (((sb >> 9) & 1) << 5); R = (st >> 1) * 16 + swz / 64; C = (st & 1) * 32 + (swz % 64) / 2; }
__device__ __forceinline__ int perm32(int rho) { const int n = rho >> 4, i = rho & 15; return 8 * (i >> 2) + 4 * n + (i & 3); }
struct Unit { int pm, pn; };
struct StaticOrder {
    int nM, nN, nwg, G, c;
    __device__ void init(int nM_, int nN_, int G_, int c_) { nM = nM_; nN = nN_; nwg = nM * nN; G = G_; c = c_; }
    __device__ bool next(int i, Unit& u) const {
        const long L = (long)i * G + c; if (L >= nwg) return false;
        int wgid = (int)L; { const int q = nwg / NXCD, r = nwg % NXCD, xcd = wgid % NXCD, off = wgid / NXCD; wgid = (xcd < r ? xcd * (q + 1) : r * (q + 1) + (xcd - r) * q) + off; }
        const int nig = WGM * nN, gid = wgid / nig, fm = gid * WGM, gsz = (nM - fm) < WGM ? (nM - fm) : WGM;
        u.pm = fm + ((wgid % nig) % gsz); u.pn = (wgid % nig) / gsz; return true;
    }
};
__device__ __forceinline__ void halo_decode(int pm, int& seqbase, int& t0, int& slen) {
    if (pm < NBATCH * HT_P) { const int s = pm / HT_P, j = pm - s * HT_P; seqbase = s * SP; t0 = 248 * j; slen = SP; }
    else { const int q = pm - NBATCH * HT_P, s = q / HT_S, j = q - s * HT_S; seqbase = MP + s * SS; t0 = 248 * j; slen = SS; }
}

template <class Epi, bool HALO>
__device__ __forceinline__ void gemm_phase(LAS unsigned char* lds, const bf16_t* Ag, const bf16_t* Btg, const int K, const int nM, const int nN, const int G, const int cidx, const int wave_, const Epi& E) {
    int tid_ = fresh_tid(wave_); asm volatile("" : "+v"(tid_));
    const int tid = tid_, wid = __builtin_amdgcn_readfirstlane(tid >> 6), lane = tid & 63, wr = wid >> 2, wc = wid & 3, fr = lane & 15, fq = lane >> 4;
    const int nt = K / BK;
    StaticOrder S; S.init(nM, nN, G, cidx);
    unsigned voffA[2], voffB[2];
#pragma unroll
    for (int i = 0; i < 2; ++i) { int R, C; stage_rc(tid * 16 + i * 8192, R, C); const int Rb = (R & ~31) + perm32(R & 31);
        const int Ra = HALO ? (R - 2 * (R >> 6)) : R;
        voffA[i] = (unsigned)(Ra * K + C) * 2u; voffB[i] = (unsigned)(Rb * K + C) * 2u; }
    const size_t kstep = (size_t)(BK * 2);
    const size_t hstepB = (size_t)HALF * K * 2;
    const size_t hstepA = HALO ? (size_t)124 * K * 2 : hstepB;
    const unsigned ldsw = (unsigned)wid * 1024u;
    const int aoff = lds_byte(wr * 64 + fr, fq * 8), boff = lds_byte(wc * 32 + fr, fq * 8);
#define PG8_ABASE(pm_) (HALO ? ((const char*)Ag + ((long)halo_row0(pm_)) * (long)K * 2) : ((const char*)Ag + (size_t)(pm_) * 2 * hstepB))
#define PG8_BBASE(pn_) ((const char*)Btg + (size_t)(pn_) * 2 * hstepB)
#define PG8_SA(b, h) (((b) * 2 + (h)) * HTB)
#define PG8_SB(b, h) ((4 + (b) * 2 + (h)) * HTB)
#define PG8_STAGE(bufoff, gbase, voff) do { _Pragma("unroll") for (int _i = 0; _i < 2; ++_i) \
        __builtin_amdgcn_global_load_lds((const unsigned*)((const char*)(gbase) + (voff)[_i]), (LAS unsigned*)(lds + (bufoff) + ldsw + _i * 8192), 16, 0, 0); } while (0)
#define PG8_LDA(dst, b, h) do { _Pragma("unroll") for (int m = 0; m < 4; ++m) _Pragma("unroll") for (int k = 0; k < 2; ++k) dst[m][k] = *(const LAS bf16x8*)(lds + PG8_SA(b, h) + aoff + m * 2048 + k * 1024); } while (0)
#define PG8_LDB(dst, b, h) do { _Pragma("unroll") for (int n = 0; n < 2; ++n) _Pragma("unroll") for (int k = 0; k < 2; ++k) dst[n][k] = *(const LAS bf16x8*)(lds + PG8_SB(b, h) + boff + n * 2048 + k * 1024); } while (0)
#define PG8_MMA(ai, bj, At, Bt) do { __builtin_amdgcn_s_setprio(1); _Pragma("unroll") for (int m = 0; m < 4; ++m) _Pragma("unroll") for (int n = 0; n < 2; ++n) _Pragma("unroll") for (int k = 0; k < 2; ++k) \
        acc[ai][bj][m][n] = __builtin_amdgcn_mfma_f32_16x16x32_bf16(Bt[n][k], At[m][k], acc[ai][bj][m][n], 0, 0, 0); __builtin_amdgcn_s_setprio(0); } while (0)
#define PG8_WAIT_V(n) asm volatile("s_waitcnt vmcnt(" #n ")" ::: "memory")
#define PG8_WAIT_L(n) asm volatile("s_waitcnt lgkmcnt(" #n ")" ::: "memory")
#define PG8_BAR __builtin_amdgcn_s_barrier()
#define PG8_SCHED __builtin_amdgcn_sched_barrier(0)
    auto halo_row0 = [](int pm) -> long { int sb, t0, sl; halo_decode(pm, sb, t0, sl); return (long)sb + t0 - 1; };
    Unit cur, nxt; int ui = 0;
    if (!S.next(0, cur)) return;
    f32x4 acc[2][2][4][2];
#pragma unroll
    for (int a = 0; a < 2; ++a)
#pragma unroll
        for (int b = 0; b < 2; ++b)
#pragma unroll
            for (int m = 0; m < 4; ++m)
#pragma unroll
                for (int n = 0; n < 2; ++n) acc[a][b][m][n] = (f32x4){0.f, 0.f, 0.f, 0.f};
    bf16x8 At[4][2], B0[2][2], B1[2][2];
    const char* cA = PG8_ABASE(cur.pm); const char* cB = PG8_BBASE(cur.pn);
    PG8_STAGE(PG8_SB(0, 0), cB, voffB); PG8_STAGE(PG8_SB(0, 1), cB + hstepB, voffB); PG8_STAGE(PG8_SA(0, 0), cA, voffA); PG8_STAGE(PG8_SA(0, 1), cA + hstepA, voffA);
    if (wr == 1) PG8_BAR;
    PG8_WAIT_V(2); PG8_BAR;
    PG8_STAGE(PG8_SB(1, 0), cB + kstep, voffB); PG8_STAGE(PG8_SA(1, 0), cA + kstep, voffA); PG8_STAGE(PG8_SB(1, 1), cB + hstepB + kstep, voffB);
    PG8_WAIT_V(6); PG8_BAR;
    for (;;) {
        const bool has_next = S.next(ui + 1, nxt);
        const char* nA = has_next ? PG8_ABASE(nxt.pm) : cA; const char* nB = has_next ? PG8_BBASE(nxt.pn) : cB;
        for (int t = 0; t < nt; t += 2) {
            const bool last = (t == nt - 2);
            const char* a1 = cA + (size_t)(t + 1) * kstep;
            const char* a2 = last ? nA : cA + (size_t)(t + 2) * kstep; const char* b2 = last ? nB : cB + (size_t)(t + 2) * kstep;
            const char* a3 = a2 + kstep; const char* b3 = b2 + kstep;
            PG8_LDB(B0, 0, 0); PG8_LDB(B1, 0, 1); PG8_SCHED; PG8_LDA(At, 0, 0); PG8_STAGE(PG8_SA(1, 1), a1 + hstepA, voffA);
            PG8_WAIT_V(8); PG8_WAIT_L(0); PG8_BAR; PG8_MMA(0, 0, At, B0); PG8_MMA(0, 1, At, B1); PG8_BAR; PG8_SCHED;
            PG8_LDA(At, 0, 1); PG8_STAGE(PG8_SB(0, 0), b2, voffB); PG8_STAGE(PG8_SB(0, 1), b2 + hstepB, voffB); PG8_STAGE(PG8_SA(0, 0), a2, voffA);
            PG8_WAIT_V(8); PG8_WAIT_L(0); PG8_BAR; PG8_MMA(1, 0, At, B0); PG8_MMA(1, 1, At, B1); PG8_BAR; PG8_SCHED;
            PG8_LDB(B0, 1, 0); PG8_LDB(B1, 1, 1); PG8_SCHED; PG8_LDA(At, 1, 0); PG8_STAGE(PG8_SA(0, 1), a2 + hstepA, voffA);
            PG8_WAIT_V(8); PG8_WAIT_L(0); PG8_BAR; PG8_MMA(0, 0, At, B0); PG8_MMA(0, 1, At, B1); PG8_BAR; PG8_SCHED;
            PG8_LDA(At, 1, 1); PG8_STAGE(PG8_SB(1, 0), b3, voffB); PG8_STAGE(PG8_SB(1, 1), b3 + hstepB, voffB); PG8_STAGE(PG8_SA(1, 0), a3, voffA);
            PG8_WAIT_V(8); PG8_WAIT_L(0); PG8_BAR; PG8_MMA(1, 0, At, B0); PG8_MMA(1, 1, At, B1); PG8_BAR; PG8_SCHED;
        }
        if (wr == 0) PG8_BAR;
        E(acc, cur, wr, wc, fr, fq);
        if (!has_next) break;
#pragma unroll
        for (int a = 0; a < 2; ++a)
#pragma unroll
            for (int b = 0; b < 2; ++b)
#pragma unroll
                for (int m = 0; m < 4; ++m)
#pragma unroll
                    for (int n = 0; n < 2; ++n) acc[a][b][m][n] = (f32x4){0.f, 0.f, 0.f, 0.f};
        cur = nxt; cA = nA; cB = nB; ++ui;
        if (wr == 1) PG8_BAR;
    }
    PG8_WAIT_V(0);
    PG8_BAR;
#undef PG8_ABASE
#undef PG8_BBASE
#undef PG8_SA
#undef PG8_SB
#undef PG8_STAGE
#undef PG8_LDA
#undef PG8_LDB
#undef PG8_MMA
#undef PG8_WAIT_V
#undef PG8_WAIT_L
#undef PG8_BAR
#undef PG8_SCHED
}

struct EpiZ {
    bf16_t* Z; int ldz; const float* gtab; unsigned normmask; const float* PS;
    __device__ __forceinline__ void operator()(const f32x4 (&acc)[2][2][4][2], const Unit& u, int wr, int wc, int fr, int fq) const {
        const bool nrm = (normmask >> u.pn) & 1u;
        f32x4 gv[2][2];
#pragma unroll
        for (int bj = 0; bj < 2; ++bj)
#pragma unroll
            for (int n = 0; n < 2; ++n) gv[bj][n] = nrm ? *(const f32x4*)(gtab + u.pn * 64 + 32 * bj + 8 * fq + 4 * n) : (f32x4){1.f, 1.f, 1.f, 1.f};
#pragma unroll
        for (int ai = 0; ai < 2; ++ai)
#pragma unroll
            for (int m = 0; m < 4; ++m) {
                const int row = u.pm * BM + ai * HALF + wr * 64 + m * 16 + fr;
                float rs = 1.f;
                if (PS) { const f32x4 p = *(const f32x4*)(PS + (size_t)row * 16 + 4 * fq); float s = (p[0] + p[1]) + (p[2] + p[3]); s = bfly_add<16>(s); s = bfly_add<32>(s); rs = rsqrtf(s * (1.f / DM) + EPS); }
                f32x4 v[2][2]; float ss = 0.f;
#pragma unroll
                for (int bj = 0; bj < 2; ++bj)
#pragma unroll
                    for (int n = 0; n < 2; ++n) { v[bj][n] = acc[ai][bj][m][n] * rs; const f32x4 x = v[bj][n]; ss += (x[0] * x[0] + x[1] * x[1]) + (x[2] * x[2] + x[3] * x[3]); }
                if (nrm) { ss = bfly_add<16>(ss); ss = bfly_add<32>(ss); const float r2 = rsqrtf(ss * (1.f / 64.f) + EPS);
#pragma unroll
                    for (int bj = 0; bj < 2; ++bj)
#pragma unroll
                        for (int n = 0; n < 2; ++n) v[bj][n] = v[bj][n] * r2 * gv[bj][n]; }
                bf16_t* rowp = Z + (size_t)row * ldz + u.pn * BM + 64 * wc + 8 * fq;
#pragma unroll
                for (int bj = 0; bj < 2; ++bj) { u32x4 w; w.x = cvtpk(v[bj][0][0], v[bj][0][1]); w.y = cvtpk(v[bj][0][2], v[bj][0][3]); w.z = cvtpk(v[bj][1][0], v[bj][1][1]); w.w = cvtpk(v[bj][1][2], v[bj][1][3]);
                    *(u32x4*)(rowp + 32 * bj) = w; }
                { asm volatile("" ::: "memory"); __builtin_amdgcn_sched_barrier(0); }
            }
    }
};

struct EpiRes {
    const float* xin_p; const float* xin_s; bf16_t* XR; float* fout; float* PS;
    __device__ __forceinline__ void operator()(const f32x4 (&acc)[2][2][4][2], const Unit& u, int wr, int wc, int fr, int fq) const {
#pragma unroll
        for (int ai = 0; ai < 2; ++ai)
#pragma unroll
            for (int m = 0; m < 4; ++m) {
                const int row = u.pm * BM + ai * HALF + wr * 64 + m * 16 + fr;
                float ss = 0.f;
#pragma unroll
                for (int bj = 0; bj < 2; ++bj) { const int col = u.pn * BM + bj * HALF + wc * 32 + 8 * fq;
                    f32x4 v0, v1;
                    if (xin_p) { const float* xr = (row < MP ? xin_p + (size_t)row * DM : xin_s + (size_t)(row - MP) * DM) + col; v0 = *(const f32x4*)xr; v1 = *(const f32x4*)(xr + 4); }
                    else { const u32x4 w = *(const u32x4*)(XR + (size_t)row * DM + col);
                        v0 = (f32x4){__uint_as_float(w.x << 16), __uint_as_float(w.x & 0xffff0000u), __uint_as_float(w.y << 16), __uint_as_float(w.y & 0xffff0000u)};
                        v1 = (f32x4){__uint_as_float(w.z << 16), __uint_as_float(w.z & 0xffff0000u), __uint_as_float(w.w << 16), __uint_as_float(w.w & 0xffff0000u)}; }
                    v0 = v0 + acc[ai][bj][m][0]; v1 = v1 + acc[ai][bj][m][1];
                    if (fout) { *(f32x4*)(fout + (size_t)row * DM + col) = v0; *(f32x4*)(fout + (size_t)row * DM + col + 4) = v1; }
                    else { u32x4 w; w.x = cvtpk(v0[0], v0[1]); w.y = cvtpk(v0[2], v0[3]); w.z = cvtpk(v1[0], v1[1]); w.w = cvtpk(v1[2], v1[3]); *(u32x4*)(XR + (size_t)row * DM + col) = w; }
                    if (PS) ss += (v0[0] * v0[0] + v0[1] * v0[1]) + (v0[2] * v0[2] + v0[3] * v0[3]) + (v1[0] * v1[0] + v1[1] * v1[1]) + (v1[2] * v1[2] + v1[3] * v1[3]); }
                if (PS) { ss = bfly_add<16>(ss); ss = bfly_add<32>(ss); if (fq == 0) PS[(size_t)row * 16 + 4 * u.pn + wc] = ss; }
                { asm volatile("" ::: "memory"); __builtin_amdgcn_sched_barrier(0); }
            }
    }
};
struct EpiConv {
    bf16_t* Gout; const float* CT; const float* PS;
    __device__ __forceinline__ void operator()(const f32x4 (&acc)[2][2][4][2], const Unit& u, int wr, int wc, int fr, int fq) const {
        int seqbase, t0, slen; halo_decode(u.pm, seqbase, t0, slen);
        const f32x4* ct = (const f32x4*)(CT + (size_t)(128 * u.pn) * 8) + (32 * wc + 8 * fq) * 2;
        const bool f0 = (fr == 0), f15 = (fr == 15);
#pragma unroll
        for (int ai = 0; ai < 2; ++ai) {
            const int tbase = t0 + 62 * (2 * ai + wr) - 1;
            float rs[4];
#pragma unroll
            for (int m = 0; m < 4; ++m) { const int t = tbase + 16 * m + fr; const bool vin = (t >= 0) && (t < slen); const int grow = seqbase + (vin ? t : 0);
                const f32x4 p = *(const f32x4*)(PS + (size_t)grow * 16 + 4 * fq); float s = (p[0] + p[1]) + (p[2] + p[3]); s = bfly_add<16>(s); s = bfly_add<32>(s); rs[m] = vin ? rsqrtf(s * (1.f / DM) + EPS) : 0.f; }
            unsigned outw[4][2][2];
#pragma unroll
            for (int n = 0; n < 2; ++n)
#pragma unroll
                for (int jp = 0; jp < 2; ++jp) {
                    const int cidx = (4 * n + 2 * jp) * 2;
                    const f32x4 c0a = ct[cidx], c0b = ct[cidx + 1], c1a = ct[cidx + 2], c1b = ct[cidx + 3];
                    const f32x2 wv0 = {c0a[0], c1a[0]}, wv1 = {c0a[1], c1a[1]}, wv2 = {c0a[2], c1a[2]}, bv = {c0a[3], c1a[3]};
                    const f32x2 wg0 = {c0b[0], c1b[0]}, wg1 = {c0b[1], c1b[1]}, wg2 = {c0b[2], c1b[2]}, bg = {c0b[3], c1b[3]};
                    f32x2 uv[4], ug[4], cv[4];
#pragma unroll
                    for (int m = 0; m < 4; ++m) { uv[m] = (f32x2){acc[ai][0][m][n][2 * jp], acc[ai][0][m][n][2 * jp + 1]}; ug[m] = (f32x2){acc[ai][1][m][n][2 * jp], acc[ai][1][m][n][2 * jp + 1]}; }
                    asm volatile("" : "+v"(uv[0]), "+v"(uv[1]), "+v"(uv[2]), "+v"(uv[3]), "+v"(ug[0]), "+v"(ug[1]), "+v"(ug[2]), "+v"(ug[3]));
                    {
                        f32x2 rv[4], lv[4];
#pragma unroll
                        for (int m = 0; m < 4; ++m) { uv[m] = uv[m] * rs[m]; rv[m] = (f32x2){dpp_ror1(uv[m][0]), dpp_ror1(uv[m][1])}; lv[m] = (f32x2){dpp_ror15(uv[m][0]), dpp_ror15(uv[m][1])}; }
#pragma unroll
                        for (int m = 0; m < 4; ++m) { const f32x2 pv_ = (m > 0 && f0) ? rv[m > 0 ? m - 1 : 0] : rv[m], nv_ = (m < 3 && f15) ? lv[m < 3 ? m + 1 : 3] : lv[m];
                            cv[m] = bv + wv0 * pv_ + wv1 * uv[m] + wv2 * nv_; }
                    }
                    asm volatile("" : "+v"(cv[0]), "+v"(cv[1]), "+v"(cv[2]), "+v"(cv[3]));
                    {
                        f32x2 rg[4], lg[4];
#pragma unroll
                        for (int m = 0; m < 4; ++m) { ug[m] = ug[m] * rs[m]; rg[m] = (f32x2){dpp_ror1(ug[m][0]), dpp_ror1(ug[m][1])}; lg[m] = (f32x2){dpp_ror15(ug[m][0]), dpp_ror15(ug[m][1])}; }
#pragma unroll
                        for (int m = 0; m < 4; ++m) { const f32x2 pg_ = (m > 0 && f0) ? rg[m > 0 ? m - 1 : 0] : rg[m], ng_ = (m < 3 && f15) ? lg[m < 3 ? m + 1 : 3] : lg[m];
                            const f32x2 cgt = bg + wg0 * pg_ + wg1 * ug[m] + wg2 * ng_;
                            const f32x2 e = cgt * (-LOG2E);
                            const f32x2 d = (f32x2){__builtin_amdgcn_exp2f(e[0]), __builtin_amdgcn_exp2f(e[1])} + 1.f;
                            const f32x2 sg = {__builtin_amdgcn_rcpf(d[0]), __builtin_amdgcn_rcpf(d[1])};
                            const f32x2 ov = cv[m] * cgt * sg;
                            outw[m][n][jp] = cvtpk(ov[0], ov[1]); }
                    }
                    asm volatile("" : "+v"(outw[0][n][jp]), "+v"(outw[1][n][jp]), "+v"(outw[2][n][jp]), "+v"(outw[3][n][jp]) :: "memory"); __builtin_amdgcn_sched_barrier(0);
                }
#pragma unroll
            for (int m = 0; m < 4; ++m) { const int i = 16 * m + fr, t = tbase + i;
                if (i >= 1 && i <= 62 && t < slen) { u32x4 w; w.x = outw[m][0][0]; w.y = outw[m][0][1]; w.z = outw[m][1][0]; w.w = outw[m][1][1];
                    *(u32x4*)(Gout + (size_t)(seqbase + t) * DFF + 128 * u.pn + 32 * wc + 8 * fq) = w; } }
            { asm volatile("" ::: "memory"); __builtin_amdgcn_sched_barrier(0); }
        }
    }
};
}

namespace att {
constexpr int QBLK = 32, KVBLK = 64;
constexpr size_t SHM_V = KVBLK * 128 * 2, SHM_K = KVBLK * 128 * 2;
constexpr int OFF_WS = 65536, OFF_LUTA = 68 * 1024, LUTA_STRIDE = 644, OFF_LUTB = 80 * 1024, OFF_MISC = 112 * 1024;
constexpr float NEG = -1e30f;
#define KSWZ(row, colB) ((row) * 256 + ((colB) ^ (((row) & 7) << 4)))
#define SBAR() __builtin_amdgcn_sched_barrier(0)
__device__ __forceinline__ int crow(int r, int hi) { return (r & 3) + 8 * (r >> 2) + 4 * hi; }
__device__ __forceinline__ void expHalf(f32x16& p0) {
#pragma unroll
    for (int r = 0; r < 16; ++r) p0[r] = __builtin_amdgcn_exp2f(p0[r]);
}
__device__ __forceinline__ void finishSM(f32x16& p0, f32x16& p1, float& l_reg, bf16x8& pa0, bf16x8& pa1, bf16x8& pa2, bf16x8& pa3) {
    float ps = 0;
#pragma unroll
    for (int r = 0; r < 16; ++r) ps += p0[r];
#pragma unroll
    for (int r = 0; r < 16; ++r) ps += p1[r];
    l_reg += ps;
#define PK4(P, BASE, OUT) do { unsigned a0 = cvtpk(P[BASE + 0], P[BASE + 1]), a1 = cvtpk(P[BASE + 2], P[BASE + 3]);   \
    unsigned b0 = cvtpk(P[BASE + 4], P[BASE + 5]), b1 = cvtpk(P[BASE + 6], P[BASE + 7]);                              \
    auto r0 = __builtin_amdgcn_permlane32_swap(a0, b0, false, false); auto r1 = __builtin_amdgcn_permlane32_swap(a1, b1, false, false); \
    u32x4 w = {r0[0], r1[0], r0[1], r1[1]}; OUT = __builtin_bit_cast(bf16x8, w); } while (0)
    PK4(p0, 0, pa0); PK4(p0, 8, pa1); PK4(p1, 0, pa2); PK4(p1, 8, pa3);
#undef PK4
}
__device__ __forceinline__ void qkt(f32x16& p0, f32x16& p1, const char* Ks, const bf16x8* qr, float c0, int r32, int hi, int half) {
#define KFRAG(d0, row) (*reinterpret_cast<const bf16x8*>(Ks + KSWZ((row), (half * 64 + (d0) * 16 + hi * 8) * 2)))
    bf16x8 a0 = KFRAG(0, r32), a1 = KFRAG(0, 32 + r32), b0 = KFRAG(1, r32), b1 = KFRAG(1, 32 + r32);
    SBAR();
#pragma unroll
    for (int r = 0; r < 16; ++r) { p0[r] = c0; p1[r] = c0; }
    SBAR();
    p0 = __builtin_amdgcn_mfma_f32_32x32x16_bf16(a0, qr[0], p0, 0, 0, 0); p1 = __builtin_amdgcn_mfma_f32_32x32x16_bf16(a1, qr[0], p1, 0, 0, 0);
    a0 = KFRAG(2, r32); a1 = KFRAG(2, 32 + r32);
    SBAR();
    p0 = __builtin_amdgcn_mfma_f32_32x32x16_bf16(b0, qr[1], p0, 0, 0, 0); p1 = __builtin_amdgcn_mfma_f32_32x32x16_bf16(b1, qr[1], p1, 0, 0, 0);
    b0 = KFRAG(3, r32); b1 = KFRAG(3, 32 + r32);
    SBAR();
    p0 = __builtin_amdgcn_mfma_f32_32x32x16_bf16(a0, qr[2], p0, 0, 0, 0); p1 = __builtin_amdgcn_mfma_f32_32x32x16_bf16(a1, qr[2], p1, 0, 0, 0);
    p0 = __builtin_amdgcn_mfma_f32_32x32x16_bf16(b0, qr[3], p0, 0, 0, 0); p1 = __builtin_amdgcn_mfma_f32_32x32x16_bf16(b1, qr[3], p1, 0, 0, 0);
#undef KFRAG
}
__device__ __forceinline__ int v_st(int k, int c) { const int kk = (k & ~0xC) | ((k & 4) << 1) | ((k & 8) >> 1); return ((kk >> 3) * 4 + (c >> 5)) * 512 + ((kk & 7) * 32 + (c & 31)) * 2; }
__device__ __forceinline__ int v_rd_base(int lane) { return ((lane & 3) << 3) | (((lane >> 2) & 3) << 6) | (((lane >> 4) & 1) << 5) | (((lane >> 5) & 1) << 8); }
constexpr int v_rd_off(int d0, int ks, int half) { return d0 * 512 + ks * 4096 + half * 2048; }
template <int OFF> __device__ __forceinline__ s16x4 tr_read(int vb) { s16x4 r; asm volatile("ds_read_b64_tr_b16 %0, %1 offset:%2" : "=&v"(r) : "v"(vb), "i"(OFF) : "memory"); return r; }
#define PVLOAD(D0, X) do { X[0] = tr_read<v_rd_off(D0, 0, 0)>(vb); X[1] = tr_read<v_rd_off(D0, 0, 1)>(vb); X[2] = tr_read<v_rd_off(D0, 1, 0)>(vb); X[3] = tr_read<v_rd_off(D0, 1, 1)>(vb); \
    X[4] = tr_read<v_rd_off(D0, 2, 0)>(vb); X[5] = tr_read<v_rd_off(D0, 2, 1)>(vb); X[6] = tr_read<v_rd_off(D0, 3, 0)>(vb); X[7] = tr_read<v_rd_off(D0, 3, 1)>(vb); } while (0)
#define PVPK(L, H) (bf16x8){L[0], L[1], L[2], L[3], H[0], H[1], H[2], H[3]}
#define PVMMA(OD, X) do { OD = __builtin_amdgcn_mfma_f32_32x32x16_bf16(pa0, PVPK(X[0], X[1]), OD, 0, 0, 0); OD = __builtin_amdgcn_mfma_f32_32x32x16_bf16(pa1, PVPK(X[2], X[3]), OD, 0, 0, 0); \
    OD = __builtin_amdgcn_mfma_f32_32x32x16_bf16(pa2, PVPK(X[4], X[5]), OD, 0, 0, 0); OD = __builtin_amdgcn_mfma_f32_32x32x16_bf16(pa3, PVPK(X[6], X[7]), OD, 0, 0, 0); } while (0)
#define PVWAIT() do { asm volatile("s_waitcnt lgkmcnt(0)" ::: "memory"); SBAR(); } while (0)
template <int NB> __device__ __forceinline__ void pv_blocks(f32x16* o, int vb, bf16x8 pa0, bf16x8 pa1, bf16x8 pa2, bf16x8 pa3, f32x16& pe0, f32x16& pe1) {
    s16x4 x[8], y[8];
#define PVEXP(P, B, N) do { _Pragma("unroll") for (int r = (B); r < (B) + (N); ++r) P[r] = __builtin_amdgcn_exp2f(P[r]); } while (0)
    PVLOAD(0, x); PVWAIT();
    if (NB == 4) {
        PVLOAD(1, y); SBAR(); PVMMA(o[0], x); PVEXP(pe0, 0, 8); SBAR(); PVWAIT();
        PVLOAD(2, x); SBAR(); PVMMA(o[1], y); PVEXP(pe0, 8, 8); SBAR(); PVWAIT();
        PVLOAD(3, y); SBAR(); PVMMA(o[2], x); PVEXP(pe1, 0, 8); SBAR(); PVWAIT();
        PVMMA(o[3], y); PVEXP(pe1, 8, 8);
    } else {
        PVLOAD(1, y); SBAR(); PVMMA(o[0], x); PVEXP(pe0, 0, 16); SBAR(); PVWAIT();
        PVMMA(o[1], y); PVEXP(pe1, 0, 16);
    }
#undef PVEXP
}
#undef PVLOAD
#undef PVPK
#undef PVMMA
#undef PVWAIT

struct UnitArgs {
    const bf16_t* Qb;
    const bf16_t* Kb;
    const bf16_t* Vb;
    bf16_t* Ob;
    int ldk;
    int NT;
    int tile0, R;
    int q0;
    int h;
    float farL, farR, lam, oscale;
    float mshift;
    const float* subg;
};

template <int MODE>
__device__ __forceinline__ void attn_unit(const UnitArgs& A, char* lds, const int wave_) {
    int tid_ = fresh_tid(wave_); asm volatile("" : "+v"(tid_));
    const int tid = tid_, wid = __builtin_amdgcn_readfirstlane(tid >> 6), lane = tid & 63, r32 = lane & 31, hi = lane >> 5;
    const int qb = wid & 3, half = wid >> 2;
    if (wid >= 4) __builtin_amdgcn_s_setprio(1);
    char* V_lds = lds; char* K_lds = lds + 2 * SHM_V;
    float* ws = (float*)(lds + OFF_WS) + wid * 64; float* li_l = ws;
    const float* lutA = (const float*)(lds + OFF_LUTA); const float* lutB = (const float*)(lds + OFF_LUTB);
    float l_reg = 0; f32x16 o[4] = {}; bf16x8 qr[4];
    { const bf16_t* Qw = A.Qb + (long)(qb * QBLK + r32) * NZ + half * 64 + hi * 8;
#pragma unroll
      for (int d0 = 0; d0 < 4; ++d0) qr[d0] = *reinterpret_cast<const bf16x8*>(Qw + d0 * 16); }
    const int sr = tid >> 4, sc = (tid & 15) * 8, vst0 = v_st(sr, sc), kst0 = KSWZ(sr, sc * 2);
    const int vbase = (int)(uintptr_t)V_lds + v_rd_base(lane) + (MODE == 0 ? 0 : half * 1024);
    const int ldk = A.ldk; const unsigned ldoff = (unsigned)(sr * ldk + sc) * 2u;
    struct { bf16x8 vs0, vs1, ks0, ks1; } sr_[1];
#define TROW(t) (MODE == 1 ? 64 * ((A.tile0 + (t)) < A.R ? (A.tile0 + (t)) : (A.R - 1)) : 64 * (t))
#define SLOAD(i, t) do { const size_t tb_ = (size_t)TROW(t) * ldk * 2; const char* kb_ = (const char*)A.Kb + tb_; const char* vb_ = (const char*)A.Vb + tb_; const size_t h_ = (size_t)32 * ldk * 2; \
    sr_[i].vs0 = *(const bf16x8*)(vb_ + ldoff); sr_[i].vs1 = *(const bf16x8*)(vb_ + h_ + ldoff); sr_[i].ks0 = *(const bf16x8*)(kb_ + ldoff); sr_[i].ks1 = *(const bf16x8*)(kb_ + h_ + ldoff); } while (0)
#define SWRITE(b, i) do { *(bf16x8*)(V_lds + (b) * (int)SHM_V + vst0) = sr_[i].vs0; *(bf16x8*)(V_lds + (b) * (int)SHM_V + vst0 + 8192) = sr_[i].vs1; \
    *(bf16x8*)(K_lds + (b) * SHM_K + kst0) = sr_[i].ks0; *(bf16x8*)(K_lds + (b) * SHM_K + kst0 + 8192) = sr_[i].ks1; } while (0)
#define SWAIT() asm volatile("s_waitcnt vmcnt(0)" ::: "memory")
    auto zone_of = [&](int t) -> int { const int k0 = 64 * t, qw0 = A.q0 + 32 * qb; return (k0 + 63 - qw0 <= -128) ? 0 : ((k0 - qw0 - 31 >= 128) ? 2 : 1); };
#define QK(P0, P1, KS, t) do { float v_ = -A.mshift; if (MODE == 0) { const int z_ = zone_of(t); v_ += (z_ == 0 ? A.farL : (z_ == 2 ? A.farR : 0.f)); } \
    qkt(P0, P1, KS, qr, v_, r32, hi, half); } while (0)
    auto post = [&](f32x16& p0, f32x16& p1, int t) {
        SBAR();
        if (MODE == 0) {
            if (zone_of(t) == 1) { const int k0 = 64 * t, qw0 = A.q0 + 32 * qb;
                const float* b = lutA + A.h * LUTA_STRIDE + (k0 - qw0 - r32 + 4 * hi + 320);
#pragma unroll
                for (int r = 0; r < 16; ++r) { const int c = (r & 3) + 8 * (r >> 2); p0[r] += b[c]; p1[r] += b[32 + c]; } }
        } else if (MODE == 1) {
            const int kr = A.tile0 + t, rq = A.q0 + (qb >> 1);
            int rs = rq - 4; rs = rs < 0 ? 0 : rs; rs = rs > A.R - 8 ? A.R - 8 : rs;
            if (kr < rs || kr >= rs + 8) {
#pragma unroll
                for (int r = 0; r < 16; ++r) { p0[r] = NEG; p1[r] = NEG; }
            } else {
                const int c = 32 * (qb & 1) + r32; int cs = c - 8; cs = cs < 0 ? 0 : cs; cs = cs > 48 ? 48 : cs;
                const float* b = lutB + ((2 * A.h + half) * 15 + (kr - rq + 7)) * 128 + 64 + 4 * hi - c;
#pragma unroll
                for (int r = 0; r < 16; ++r) { const int cc = (r & 3) + 8 * (r >> 2), j = 4 * hi + cc;
                    p0[r] = ((unsigned)(j - cs) < 16u) ? p0[r] + b[cc] : NEG; p1[r] = ((unsigned)(j + 32 - cs) < 16u) ? p1[r] + b[32 + cc] : NEG; } }
        }
        SBAR();
    };
#define PV(buf, PE0, PE1) pv_blocks<(MODE == 0 ? 4 : 2)>(o, vbase + (buf) * (int)SHM_V, pa0, pa1, pa2, pa3, PE0, PE1)
    f32x16 pA0, pA1, pB0, pB1; bf16x8 pa0, pa1, pa2, pa3; const int NT = A.NT;
    SLOAD(0, 0); asm volatile("s_waitcnt vmcnt(0)" ::: "memory"); SWRITE(0, 0); SLOAD(0, 1); __syncthreads();
    QK(pA0, pA1, K_lds, 0); post(pA0, pA1, 0); expHalf(pA0); expHalf(pA1);
    SWAIT(); SWRITE(1, 0); __syncthreads();
    for (int j = 1; j + 1 < NT; j += 2) {
        SBAR(); QK(pB0, pB1, K_lds + SHM_K, j);
        finishSM(pA0, pA1, l_reg, pa0, pa1, pa2, pa3); SBAR();
        SLOAD(0, j + 1); SBAR();
        post(pB0, pB1, j); PV(0, pB0, pB1);
        __syncthreads(); SWAIT(); SWRITE(0, 0);
        __syncthreads();
        SBAR(); QK(pA0, pA1, K_lds, j + 1);
        finishSM(pB0, pB1, l_reg, pa0, pa1, pa2, pa3); SBAR();
        SLOAD(0, j + 2); SBAR();
        post(pA0, pA1, j + 1); PV(1, pA0, pA1);
        __syncthreads(); SWAIT(); SWRITE(1, 0);
        __syncthreads();
    }
    SBAR(); QK(pB0, pB1, K_lds + SHM_K, NT - 1);
    finishSM(pA0, pA1, l_reg, pa0, pa1, pa2, pa3); SBAR();
    post(pB0, pB1, NT - 1); PV(0, pB0, pB1);
    finishSM(pB0, pB1, l_reg, pa0, pa1, pa2, pa3); SBAR();
    PV(1, pA0, pA1);
    { auto rr = __builtin_amdgcn_permlane32_swap(__float_as_uint(l_reg), __float_as_uint(l_reg), false, false); l_reg = __uint_as_float(rr[0]) + __uint_as_float(rr[1]); }
    if (hi == 0) li_l[r32] = l_reg; asm volatile("s_waitcnt lgkmcnt(0)" ::: "memory");
    float rli[16];
#pragma unroll
    for (int r = 0; r < 16; ++r) rli[r] = __builtin_amdgcn_rcpf(li_l[crow(r, hi)]);
    if (MODE == 0) {
        __syncthreads();
        float* pb = (float*)lds + qb * (32 * 128);
        if (half == 1) {
#pragma unroll
            for (int r = 0; r < 16; ++r)
#pragma unroll
                for (int d0 = 0; d0 < 4; ++d0) pb[crow(r, hi) * 128 + d0 * 32 + r32] = o[d0][r] * rli[r] * A.lam;
        }
        __syncthreads();
        if (half == 0) {
            float ssq[16];
#pragma unroll
            for (int r = 0; r < 16; ++r) { float s = 0.f;
#pragma unroll
                for (int d0 = 0; d0 < 4; ++d0) { const float v = o[d0][r] * rli[r] - pb[crow(r, hi) * 128 + d0 * 32 + r32]; o[d0][r] = v; s += v * v; }
                ssq[r] = s; }
#pragma unroll
            for (int r = 0; r < 16; ++r) { float v = ssq[r]; v = bfly_add<1>(v); v = bfly_add<2>(v); v = bfly_add<4>(v); v = bfly_add<8>(v); v = bfly_add<16>(v); ssq[r] = v; }
            float gv[4];
#pragma unroll
            for (int d0 = 0; d0 < 4; ++d0) gv[d0] = A.subg[d0 * 32 + r32] * A.oscale;
            __hip_bfloat16* Ow = (__hip_bfloat16*)A.Ob + (long)(qb * QBLK) * DM;
#pragma unroll
            for (int r = 0; r < 16; ++r) { const float rn = rsqrtf(ssq[r] * (1.f / 128.f) + EPS); const int orow = crow(r, hi);
#pragma unroll
                for (int d0 = 0; d0 < 4; ++d0) Ow[(long)orow * DM + d0 * 32 + r32] = __float2bfloat16(o[d0][r] * rn * gv[d0]); }
        }
    } else {
        __hip_bfloat16* Ow = (__hip_bfloat16*)A.Ob + (long)(qb * QBLK) * DM + half * 64;
#pragma unroll
        for (int r = 0; r < 16; ++r) { const int orow = crow(r, hi);
#pragma unroll
            for (int d0 = 0; d0 < 2; ++d0) Ow[(long)orow * DM + d0 * 32 + r32] = __float2bfloat16(o[d0][r] * rli[r]); }
    }
    __builtin_amdgcn_s_setprio(0);
    __syncthreads();
#undef TROW
#undef SLOAD
#undef SWRITE
#undef SWAIT
#undef PV
#undef QK
}
#undef KSWZ
#undef SBAR
}

constexpr int LDS_BYTES = 131072 + 1024;
constexpr int OFF_BARST = 131072 + 512;
struct Args { const float* in[27]; float* out; unsigned char* ws; long long pad; };
enum { I_XP = 0, I_XS, I_MEMP, I_MEMS, I_N1G, I_WIN, I_QNA, I_KNA, I_LQ1, I_LK1, I_LQ2, I_LK2, I_SUBG, I_RELB, I_QNB, I_KNB, I_NAB, I_MEMG, I_WMEM, I_QNC, I_KNC, I_WOUT, I_N2G, I_WUP, I_CW, I_CB, I_WDN };

__device__ __forceinline__ void transpose_item(const float* W, int K, int N, bf16_t* WT, int kb, int n0, int src0, LAS float* scr, int lane, const float* gk = nullptr) {
    const int k0 = 64 * kb;
#pragma unroll 8
    for (int i = 0; i < 32; ++i) { const int kk = 2 * i + (lane >> 5); scr[kk * 33 + (lane & 31)] = W[(size_t)(k0 + kk) * N + src0 + (lane & 31)] * (gk ? gk[k0 + kk] : 1.f); }
    asm volatile("s_waitcnt lgkmcnt(0)" ::: "memory");
    const int c = lane & 7;
#pragma unroll
    for (int j = 0; j < 4; ++j) { const int n = (lane >> 3) + 8 * j; const LAS float* s = scr + (8 * c) * 33 + n;
        u32x4 o; o.x = cvtpk(s[0 * 33], s[1 * 33]); o.y = cvtpk(s[2 * 33], s[3 * 33]); o.z = cvtpk(s[4 * 33], s[5 * 33]); o.w = cvtpk(s[6 * 33], s[7 * 33]);
        *(u32x4*)(WT + (size_t)(n0 + n) * K + k0 + 8 * c) = o; }
    asm volatile("s_waitcnt lgkmcnt(0)" ::: "memory");
}
__device__ __forceinline__ int zcol_src(int z) {
    if (z < 1024) { const int base = z < 512 ? 0 : 512, zz = z & 511, h = zz >> 7, s = (zz >> 6) & 1, d = zz & 63; return base + s * 256 + 64 * h + d; }
    return z;
}
__device__ __forceinline__ int ztile_logical(int n0) { const int pn = n0 >> 8, rem = n0 & 255, bj = rem >> 7, wc = (rem >> 5) & 3; return 256 * pn + 64 * wc + 32 * bj; }
__device__ __forceinline__ void rms_row_to_bf16(const float* xrow, const float* g, bf16_t* orow, int lane) {
    const f32x4* xr = (const f32x4*)xrow + lane; const f32x4* gr = (const f32x4*)g + lane;
    f32x4 v[4]; float s = 0.f;
#pragma unroll
    for (int j = 0; j < 4; ++j) { v[j] = xr[64 * j]; s += (v[j][0] * v[j][0] + v[j][1] * v[j][1]) + (v[j][2] * v[j][2] + v[j][3] * v[j][3]); }
    const float rstd = rsqrtf(wave_sum(s) * (1.f / DM) + EPS);
    u32x2* o8 = (u32x2*)orow + lane;
#pragma unroll
    for (int j = 0; j < 4; ++j) { const f32x4 gg = g ? gr[64 * j] : (f32x4){1.f, 1.f, 1.f, 1.f}; u32x2 w; w.x = cvtpk(v[j][0] * rstd * gg[0], v[j][1] * rstd * gg[1]); w.y = cvtpk(v[j][2] * rstd * gg[2], v[j][3] * rstd * gg[3]); o8[64 * j] = w; }
}
__device__ __forceinline__ void rms_row2_to_bf16(const float* xa, const float* xb, const float* g, bf16_t* oa, bf16_t* ob, int lane) {
    const f32x4* ra = (const f32x4*)xa + lane; const f32x4* rb = (const f32x4*)xb + lane; const f32x4* gr = (const f32x4*)g + lane;
    f32x4 va[4], vb[4]; float sa = 0.f, sb = 0.f;
#pragma unroll
    for (int j = 0; j < 4; ++j) { va[j] = ra[64 * j]; vb[j] = rb[64 * j]; }
#pragma unroll
    for (int j = 0; j < 4; ++j) { sa += (va[j][0] * va[j][0] + va[j][1] * va[j][1]) + (va[j][2] * va[j][2] + va[j][3] * va[j][3]); sb += (vb[j][0] * vb[j][0] + vb[j][1] * vb[j][1]) + (vb[j][2] * vb[j][2] + vb[j][3] * vb[j][3]); }
    const float rsa = rsqrtf(wave_sum(sa) * (1.f / DM) + EPS), rsb = rsqrtf(wave_sum(sb) * (1.f / DM) + EPS);
    u32x2* pa = (u32x2*)oa + lane; u32x2* pb = (u32x2*)ob + lane;
#pragma unroll
    for (int j = 0; j < 4; ++j) { const f32x4 gg = g ? gr[64 * j] : (f32x4){1.f, 1.f, 1.f, 1.f}; u32x2 w;
        w.x = cvtpk(va[j][0] * rsa * gg[0], va[j][1] * rsa * gg[1]); w.y = cvtpk(va[j][2] * rsa * gg[2], va[j][3] * rsa * gg[3]); pa[64 * j] = w;
        w.x = cvtpk(vb[j][0] * rsb * gg[0], vb[j][1] * rsb * gg[1]); w.y = cvtpk(vb[j][2] * rsb * gg[2], vb[j][3] * rsb * gg[3]); pb[64 * j] = w; }
}
__device__ __forceinline__ int t5_bucket(int rp) {
    const int ret = rp > 0 ? 16 : 0; const int n = rp < 0 ? -rp : rp;
    if (n < 8) return ret + n;
    int v = 8 + (n >= 12) + (n >= 16) + (n >= 23) + (n >= 32) + (n >= 46) + (n >= 64) + (n >= 91);
    return ret + (v > 15 ? 15 : v);
}


typedef unsigned int u32_t;
#define XB_TMO      128
#define XB_XCNT(j)  (256  + 64 * (j))
#define XB_XSUB(j)  (1280 + 64 * (j))
#define XB_XGEN(j)  (2304 + 64 * (j))
#define XB_TOP      3328
#define XB_TOPGEN   3392
#define XCD_BAR_WORDS 3456
#define XB_SPIN_CAP (1u << 22)
__device__ __forceinline__ unsigned xb_ld(unsigned* p)              { return __hip_atomic_load(p, __ATOMIC_RELAXED, __HIP_MEMORY_SCOPE_AGENT); }
__device__ __forceinline__ unsigned xb_add(unsigned* p, unsigned v) { return __hip_atomic_fetch_add(p, v, __ATOMIC_RELAXED, __HIP_MEMORY_SCOPE_AGENT); }
__device__ __forceinline__ unsigned xb_xcc_id() { return (unsigned)__builtin_amdgcn_s_getreg((3 << 11) | 20) & 0xFu; }
#define XB_SPIN(cond, bar) do { unsigned _sp = 0; while (cond) { __builtin_amdgcn_s_sleep(1); \
    if ((++_sp & 255u) == 0u) { if (xb_ld(&(bar)[XB_TMO])) break; if (_sp > XB_SPIN_CAP) { atomicAdd(&(bar)[XB_TMO], 1u); break; } } } } while (0)
struct XcdBarrier { unsigned* bar; unsigned x; volatile LAS unsigned* st; };
__device__ __forceinline__ XcdBarrier xcd_barrier_post(unsigned* bar, volatile LAS unsigned* st, bool t0) {
    XcdBarrier b; b.bar = bar; b.x = xb_xcc_id(); b.st = st;
    if (t0) (void)xb_add(&bar[XB_XCNT(b.x)], 1u);
    return b;
}
__device__ __forceinline__ void xcd_barrier_complete(unsigned* bar, unsigned x, unsigned& nloc, unsigned& nx) {
    const unsigned G = gridDim.x * gridDim.y * gridDim.z;
    unsigned sum, cnt, mine, sp = 0u;
    for (;;) {
        sum = 0u; cnt = 0u; mine = 0u;
#pragma unroll
        for (unsigned j = 0; j < 16; ++j) { const unsigned c = xb_ld(&bar[XB_XCNT(j)]); sum += c; cnt += (c > 0u) ? 1u : 0u; mine = (j == x) ? c : mine; }
        if (sum == G) break;
        __builtin_amdgcn_s_sleep(1);
        if ((++sp & 255u) == 0u) { if (xb_ld(&bar[XB_TMO])) break; if (sp > XB_SPIN_CAP) { atomicAdd(&bar[XB_TMO], 1u); break; } }
    }
    nloc = mine > 0u ? mine : 1u; nx = cnt > 0u ? cnt : 1u;
}
__device__ __forceinline__ void xcd_barrier(const XcdBarrier& b, bool t0) {
    asm volatile("s_waitcnt vmcnt(0)" ::: "memory");
    __syncthreads();
    if (t0) {
        unsigned* bar = b.bar;
        __builtin_amdgcn_s_waitcnt(0);
        unsigned nloc = b.st[0], nx = b.st[1];
        if (nloc == 0u) { xcd_barrier_complete(bar, b.x, nloc, nx); b.st[0] = nloc; b.st[1] = nx; }
        const unsigned old = xb_add(&bar[XB_XSUB(b.x)], 1u);
        const unsigned gen = old / nloc;
        if (old + 1u == (gen + 1u) * nloc) {
            __builtin_amdgcn_fence(__ATOMIC_RELEASE, "agent");
            asm volatile("s_waitcnt vmcnt(0)" ::: "memory");
            const unsigned og = xb_add(&bar[XB_TOP], 1u);
            const unsigned tg = og / nx;
            if (og + 1u == (tg + 1u) * nx) xb_add(&bar[XB_TOPGEN], 1u);
            else XB_SPIN(xb_ld(&bar[XB_TOPGEN]) == tg, bar);
            __builtin_amdgcn_fence(__ATOMIC_ACQUIRE, "agent");
            xb_add(&bar[XB_XGEN(b.x)], 1u);
            asm volatile("s_waitcnt vmcnt(0)" ::: "memory");
        } else {
            XB_SPIN(xb_ld(&bar[XB_XGEN(b.x)]) == gen, bar);
            __builtin_amdgcn_fence(__ATOMIC_ACQUIRE, "agent");
            asm volatile("s_waitcnt vmcnt(0)" ::: "memory");
        }
    }
    __syncthreads();
}

typedef const __attribute__((address_space(4))) struct Args* CArgsP;
#define PHASE_ENV \
    CArgsP ap_ = (CArgsP)__builtin_amdgcn_kernarg_segment_ptr(); asm volatile("" : "+s"(ap_)); \
    unsigned char* ws = ap_->ws; float* out = ap_->out; (void)out; \
    bf16_t* XN = (bf16_t*)(ws + WS_XN); bf16_t* XNM = (bf16_t*)(ws + WS_XNM); bf16_t* Z = (bf16_t*)(ws + WS_Z); bf16_t* MIX = (bf16_t*)(ws + WS_MIX); \
    bf16_t* GB = (bf16_t*)(ws + WS_G); bf16_t* MKV = (bf16_t*)(ws + WS_MKV); float* PS = (float*)(ws + WS_PS); float* GT = (float*)(ws + WS_GT); float* CT = (float*)(ws + WS_CT); \
    (void)XN; (void)XNM; (void)Z; (void)MIX; (void)GB; (void)MKV; (void)PS; (void)GT; (void)CT;

__global__ void __launch_bounds__(NTHREADS, 2) hymba_fwd(Args args) {
    extern __shared__ __attribute__((aligned(16))) unsigned char lds[];
    cg::grid_group grid = cg::this_grid();
    const int tid = threadIdx.x, lane = tid & 63, wave = __builtin_amdgcn_readfirstlane(tid >> 6);
    const int G = gridDim.x, bx = blockIdx.x;
    const int vcu = (G % 8 == 0) ? (bx % 8) * (G / 8) + bx / 8 : bx;
    LAS unsigned char* ldsl = (LAS unsigned char*)lds;
    volatile LAS unsigned* barst = (volatile LAS unsigned*)(ldsl + OFF_BARST);
    if (tid < 2) barst[tid] = 0u;
    __syncthreads();
    { CArgsP ap0 = (CArgsP)__builtin_amdgcn_kernarg_segment_ptr(); (void)xcd_barrier_post((unsigned*)(ap0->ws + WS_BAR), barst, tid == 0); }
#define GRID_BAR() do { CArgsP apb_ = (CArgsP)__builtin_amdgcn_kernarg_segment_ptr(); asm volatile("" : "+s"(apb_)); XcdBarrier b_; b_.bar = (unsigned*)(apb_->ws + WS_BAR); b_.x = xb_xcc_id(); \
        b_.st = (volatile LAS unsigned*)((LAS unsigned char*)lds + OFF_BARST); xcd_barrier(b_, fresh_tid(wave) == 0); } while (0)

    {
        PHASE_ENV
        LAS float* scr = (LAS float*)(ldsl + wave * 16384);
        const int gw = vcu * 8 + wave, NGW = G * 8;
        constexpr int I_IN = 16 * (NZ / 32), I_OUT = 16 * (DM / 32), I_UP = 16 * (NUP / 32), I_DN = (DFF / 64) * (DM / 32), I_MEM = 16 * (512 / 32), I_L = I_IN + I_OUT + I_UP + I_DN + I_MEM;
        for (int it = gw; it < 2 * I_L; it += NGW) {
            const int l = it / I_L; int r = it - l * I_L; unsigned char* wl = ws + l * WS_WL;
            if (r < I_IN) { const int nb = r % (NZ / 32), kb = r / (NZ / 32), n0 = 32 * nb; transpose_item(ap_->in[I_WIN] + (size_t)l * DM * NZ, DM, NZ, (bf16_t*)(wl + WO_IN), kb, n0, zcol_src(ztile_logical(n0)), scr, lane, ap_->in[I_N1G] + l * DM); continue; } r -= I_IN;
            if (r < I_OUT) { const int nb = r % (DM / 32), kb = r / (DM / 32), n0 = 32 * nb; transpose_item(ap_->in[I_WOUT] + (size_t)l * DM * DM, DM, DM, (bf16_t*)(wl + WO_OUT), kb, n0, n0, scr, lane); continue; } r -= I_OUT;
            if (r < I_UP) { const int nb = r % (NUP / 32), kb = r / (NUP / 32), n0 = 32 * nb; const int pn = n0 >> 8, bj = (n0 >> 7) & 1, i0 = n0 & 127;
                transpose_item(ap_->in[I_WUP] + (size_t)l * DM * NUP, DM, NUP, (bf16_t*)(wl + WO_UP), kb, n0, (bj ? DFF : 0) + 128 * pn + i0, scr, lane, ap_->in[I_N2G] + l * DM); continue; } r -= I_UP;
            if (r < I_DN) { const int nb = r % (DM / 32), kb = r / (DM / 32), n0 = 32 * nb; transpose_item(ap_->in[I_WDN] + (size_t)l * DFF * DM, DFF, DM, (bf16_t*)(wl + WO_DN), kb, n0, n0, scr, lane); continue; } r -= I_DN;
            { const int nb = r % (512 / 32), kb = r / (512 / 32), n0 = 32 * nb; transpose_item(ap_->in[I_WMEM] + (size_t)l * DM * 512, DM, 512, (bf16_t*)(wl + WO_MEM), kb, n0, ztile_logical(n0), scr, lane); }
        }
        for (int m = gw; m < MT; m += 2 * NGW) {
            const int m2 = m + NGW;
            const float* xa = m < MP ? ap_->in[I_XP] + (size_t)m * DM : ap_->in[I_XS] + (size_t)(m - MP) * DM;
            const float* xb = m2 < MP ? ap_->in[I_XP] + (size_t)m2 * DM : ap_->in[I_XS] + (size_t)((m2 < MT ? m2 : m) - MP) * DM;
            if (m2 < MT) rms_row2_to_bf16(xa, xb, nullptr, XN + (size_t)m * DM, XN + (size_t)m2 * DM, lane); else rms_row_to_bf16(xa, nullptr, XN + (size_t)m * DM, lane); }
        for (int m = gw; m < 2 * MMEM; m += NGW) { const int l = m / MMEM, r = m - l * MMEM; const float* xr = r < NBATCH * MEMT ? ap_->in[I_MEMP] + (size_t)r * DM : ap_->in[I_MEMS] + (size_t)(r - NBATCH * MEMT) * DM;
            rms_row_to_bf16(xr, ap_->in[I_MEMG] + l * DM, XNM + (size_t)m * DM, lane); }
        for (int i = bx * NTHREADS + tid; i < 2 * DFF; i += G * NTHREADS) { const int l = i / DFF, c = i - l * DFF; const float* w = ap_->in[I_CW] + (size_t)l * 3 * NUP; const float* b = ap_->in[I_CB] + (size_t)l * NUP;
            f32x4 a = {w[c], w[NUP + c], w[2 * NUP + c], b[c]}, g = {w[DFF + c], w[NUP + DFF + c], w[2 * NUP + DFF + c], b[DFF + c]}; *(f32x4*)(CT + (size_t)i * 8) = a; *(f32x4*)(CT + (size_t)i * 8 + 4) = g; }
        if (bx == 0) {
            for (int i = tid; i < 2 * 12 * 64; i += NTHREADS) { const int l = i / 768, t = (i / 64) % 12, d = i & 63; float v = 1.f;
                if (t < 2) v = ap_->in[I_QNA][l * 64 + d] * C2; else if (t < 4) v = ap_->in[I_KNA][l * 64 + d]; else if (t == 6) v = ap_->in[I_QNB][l * 64 + d] * C2; else if (t == 7) v = ap_->in[I_KNB][l * 64 + d];
                else if (t == 9) v = ap_->in[I_QNC][l * 64 + d] * C2; else if (t == 10) v = ap_->in[I_KNC][l * 64 + d];
                GT[i] = v; }
        }
    }
    grid.sync();

#pragma nounroll
    for (int l = 0; l < 2; ++l) {
        {
            PHASE_ENV unsigned char* wl = ws + l * WS_WL;
            pg8::EpiZ E{Z, NZ, GT + l * 768, 0x2CFu, l == 0 ? nullptr : PS};
            pg8::gemm_phase<pg8::EpiZ, false>(ldsl, XN, (const bf16_t*)(wl + WO_IN), DM, MT / 256, NZ / 256, G, bx, wave, E);
            pg8::EpiZ Em{MKV, 512, GT + l * 768 + 640, 0x1u, nullptr};
            pg8::gemm_phase<pg8::EpiZ, false>(ldsl, XNM + (size_t)l * MMEM * DM, (const bf16_t*)(wl + WO_MEM), DM, MMEM / 256, 2, G, bx, wave, Em);
        }
        GRID_BAR();
        {
            PHASE_ENV
            float* lutA = (float*)(lds + att::OFF_LUTA); float* lutB = (float*)(lds + att::OFF_LUTB); float* misc = (float*)(lds + att::OFF_MISC);
            int t2 = fresh_tid(wave); asm volatile("" : "+v"(t2));
            for (int i = t2; i < 4 * 641; i += NTHREADS) { const int h = i / 641, x = i - h * 641; lutA[h * att::LUTA_STRIDE + x] = ap_->in[I_RELB][t5_bucket(x - 320) * 4 + h] * LOG2E; }
            for (int i = t2; i < 4 * 15 * 128; i += NTHREADS) { const int x = i & 127, hd = i >> 7, dc = x - 49; lutB[i] = (dc >= 0 && dc <= 30) ? ap_->in[I_NAB][(size_t)l * 4 * 15 * 31 + hd * 31 + dc] * LOG2E : 0.f; }
            const int lane = t2 & 63;
            if (wave == 0) { const float a = wave_sum(ap_->in[I_LQ1][l * 64 + lane] * ap_->in[I_LK1][l * 64 + lane]), b = wave_sum(ap_->in[I_LQ2][l * 64 + lane] * ap_->in[I_LK2][l * 64 + lane]);
                const float lam_init = 0.8f - 0.6f * expf(-0.3f * (float)l); if (lane == 0) { misc[0] = expf(a) - expf(b) + lam_init; misc[1] = 1.f - lam_init; }
                auto wmax = [&](float v) { return wave_max(fabsf(v)); };
                const float gqa = wmax(ap_->in[I_QNA][l * 64 + lane]), gka = wmax(ap_->in[I_KNA][l * 64 + lane]), gqb = wmax(ap_->in[I_QNB][l * 64 + lane]), gkb = wmax(ap_->in[I_KNB][l * 64 + lane]);
                const float gqc = wmax(ap_->in[I_QNC][l * 64 + lane]), gkc = wmax(ap_->in[I_KNC][l * 64 + lane]);
                const float rbm = wmax(fmaxf(fabsf(ap_->in[I_RELB][lane]), fabsf(ap_->in[I_RELB][64 + lane])));
                float nb = 0.f; for (int i = lane; i < 4 * 15 * 31; i += 64) nb = fmaxf(nb, fabsf(ap_->in[I_NAB][(size_t)l * 4 * 15 * 31 + i])); nb = wmax(nb);
                if (lane == 0) { misc[2] = 1.02f * 64.f * C2 * gqa * gka + rbm * LOG2E; misc[3] = 1.02f * 64.f * C2 * gqb * gkb + nb * LOG2E; misc[4] = 1.02f * 64.f * C2 * gqc * gkc; } }
            __syncthreads();
#define SGPRF(x) __builtin_bit_cast(float, __builtin_amdgcn_readfirstlane(__builtin_bit_cast(int, (float)(x))))
            const float lam = SGPRF(misc[0]), oscale = SGPRF(misc[1]), mshA = SGPRF(misc[2]), mshB = SGPRF(misc[3]), mshC = SGPRF(misc[4]);
            att::UnitArgs U;
            U.subg = ap_->in[I_SUBG] + l * 128; U.lam = lam; U.oscale = oscale; U.tile0 = 0; U.R = 0;
            for (int u = vcu; u < 2560; u += G) {
                int h, qblk, S_; size_t row0;
                if (u < 2048) { const int b = (u & 255) >> 5, c = u & 31, i = u >> 8; h = i >> 1; qblk = (i & 1) * 32 + c; row0 = (size_t)b * SP; S_ = SP; }
                else { const int v = u - 2048, b = (v & 255) >> 5, c = v & 31, idx = (v >> 8) * 32 + c; h = idx >> 4; qblk = idx & 15; row0 = (size_t)MP + (size_t)b * SS; S_ = SS; }
                U.q0 = 128 * qblk; U.h = h; U.NT = S_ / 64; U.ldk = NZ; U.mshift = mshA;
                U.Qb = Z + (row0 + U.q0) * NZ + 128 * h; U.Kb = Z + row0 * NZ + 512 + 128 * h; U.Vb = Z + row0 * NZ + 1024 + 128 * h; U.Ob = MIX + (row0 + U.q0) * DM + 128 * h;
                U.farL = SGPRF(lutA[h * att::LUTA_STRIDE + 0]); U.farR = SGPRF(lutA[h * att::LUTA_STRIDE + 640]);
                att::attn_unit<0>(U, (char*)lds, wave); }
            for (int u = vcu; u < 1280; u += G) {
                int seq, blk, p, R; size_t row0;
                if (u < 1024) { p = u & 1; blk = (u >> 1) & 63; seq = u >> 7; R = SP / GW; row0 = (size_t)seq * SP; }
                else { const int v = u - 1024; p = v & 1; blk = (v >> 1) & 15; seq = v >> 5; R = SS / GW; row0 = (size_t)MP + (size_t)seq * SS; }
                const int r0 = 2 * blk; int lo = r0 - 4; lo = lo < 0 ? 0 : lo; lo = lo > R - 8 ? R - 8 : lo; int hi2 = r0 + 1 - 4; hi2 = hi2 < 0 ? 0 : hi2; hi2 = hi2 > R - 8 ? R - 8 : hi2; hi2 += 7;
                U.q0 = r0; U.h = p; U.tile0 = lo; U.R = R; U.NT = ((hi2 - lo + 1) + 1) & ~1; U.ldk = NZ; U.mshift = mshB;
                U.Qb = Z + (row0 + 128 * blk) * NZ + 1536 + 128 * p; U.Kb = Z + row0 * NZ + 1792 + 128 * p; U.Vb = Z + row0 * NZ + 2048 + 128 * p; U.Ob = MIX + (row0 + 128 * blk) * DM + 512 + 128 * p;
                att::attn_unit<1>(U, (char*)lds, wave); }
            for (int u = vcu; u < 1280; u += G) { const int p = u & 1, blk = u >> 1; const size_t row = (size_t)blk * 128;
                const int mb = row < MP ? (int)(row / SP) : NBATCH + (int)((row - MP) / SS);
                U.NT = MEMT / 64; U.ldk = 512; U.h = p; U.q0 = 0; U.mshift = mshC;
                U.Qb = Z + row * NZ + 2304 + 128 * p; U.Kb = MKV + (size_t)mb * MEMT * 512 + 128 * p; U.Vb = MKV + (size_t)mb * MEMT * 512 + 256 + 128 * p; U.Ob = MIX + row * DM + 768 + 128 * p;
                att::attn_unit<2>(U, (char*)lds, wave); }
        }
        GRID_BAR();
        {
            PHASE_ENV unsigned char* wl = ws + l * WS_WL;
            pg8::EpiRes E{l == 0 ? ap_->in[I_XP] : nullptr, l == 0 ? ap_->in[I_XS] : nullptr, XN, nullptr, PS};
            pg8::gemm_phase<pg8::EpiRes, false>(ldsl, MIX, (const bf16_t*)(wl + WO_OUT), DM, MT / 256, DM / 256, G, bx, wave, E);
        }
        GRID_BAR();
        {
            PHASE_ENV unsigned char* wl = ws + l * WS_WL;
            pg8::EpiConv E{GB, CT + (size_t)l * DFF * 8, PS};
            pg8::gemm_phase<pg8::EpiConv, true>(ldsl, XN, (const bf16_t*)(wl + WO_UP), DM, NHT, NUP / 256, G, bx, wave, E);
        }
        GRID_BAR();
        {
            PHASE_ENV unsigned char* wl = ws + l * WS_WL;
            pg8::EpiRes E{nullptr, nullptr, XN, l == 1 ? out : nullptr, l == 0 ? PS : nullptr};
            pg8::gemm_phase<pg8::EpiRes, false>(ldsl, GB, (const bf16_t*)(wl + WO_DN), DFF, MT / 256, DM / 256, G, bx, wave, E);
        }
        if (l == 0) GRID_BAR();
    }
}

extern "C" void kernel_launch(void* const* d_in, const int* in_sizes, int n_in, void* d_out, int out_size, void* d_ws, size_t ws_size, hipStream_t stream) {
    static int grid = 0;
    if (grid == 0) {
        if (n_in != 27 || out_size != MT * DM || ws_size < WS_END) { fprintf(stderr, "kernel_launch: unexpected shapes (n_in %d out %d ws %zu)\n", n_in, out_size, ws_size); grid = -1; return; }
        int dev = 0, cus = 0, per_cu = 0;
        hipGetDevice(&dev); hipDeviceGetAttribute(&cus, hipDeviceAttributeMultiprocessorCount, dev);
        if (hipFuncSetAttribute((const void*)hymba_fwd, hipFuncAttributeMaxDynamicSharedMemorySize, LDS_BYTES) != hipSuccess) { fprintf(stderr, "kernel_launch: hipFuncSetAttribute failed\n"); grid = -1; return; }
        if (hipOccupancyMaxActiveBlocksPerMultiprocessor(&per_cu, (const void*)hymba_fwd, NTHREADS, LDS_BYTES) != hipSuccess || per_cu < 1) { fprintf(stderr, "kernel_launch: occupancy query says %d blocks/CU\n", per_cu); per_cu = 1; }
        (void)hipGetLastError();
        grid = cus;
    }
    if (grid < 0) return;
    if (hipMemsetAsync((char*)d_ws + WS_BAR, 0, XCD_BAR_WORDS * 4, stream) != hipSuccess) { fprintf(stderr, "kernel_launch: memset of the barrier words failed\n"); return; }
    Args a{};
    for (int i = 0; i < 27; ++i) a.in[i] = (const float*)d_in[i];
    a.out = (float*)d_out; a.ws = (unsigned char*)d_ws; a.pad = 0;
    void* kargs[] = {&a};
    hipError_t e = hipLaunchCooperativeKernel((const void*)hymba_fwd, dim3(grid), dim3(NTHREADS), kargs, LDS_BYTES, stream);
    if (e != hipSuccess) fprintf(stderr, "kernel_launch: cooperative launch failed: %s (grid %d)\n", hipGetErrorString(e), grid);
}
```

```cpp
#include <hip/hip_runtime.h>
#include <hip/hip_cooperative_groups.h>
#include <hip/hip_bf16.h>
#include <cstdio>
#include <cstdint>
namespace cg = cooperative_groups;

#define LAS __attribute__((address_space(3)))
typedef unsigned short bf16_t;
typedef short bf16x8 __attribute__((ext_vector_type(8)));
typedef short s16x4 __attribute__((ext_vector_type(4)));
typedef float f32x4 __attribute__((ext_vector_type(4)));
typedef float f32x2 __attribute__((ext_vector_type(2)));
typedef float f32x16 __attribute__((ext_vector_type(16)));
typedef unsigned u32x4 __attribute__((ext_vector_type(4)));
typedef unsigned u32x2 __attribute__((ext_vector_type(2)));
typedef __bf16 bf16x2_t __attribute__((ext_vector_type(2)));

constexpr int DM = 1024, NBATCH = 8, SP = 8192, SS = 2048, MP = NBATCH * SP, MS = NBATCH * SS, MT = MP + MS;
constexpr int NZ = 2560, DFF = 2816, NUP = 2 * DFF, MEMT = 256, MMEM = 2 * NBATCH * MEMT;
constexpr int GW = 64;
constexpr float EPS = 1e-6f, LOG2E = 1.4426950408889634f, C2 = 0.125f * LOG2E;
constexpr int NTHREADS = 512;
constexpr int HT_P = 34, HT_S = 9, NHT = NBATCH * HT_P + NBATCH * HT_S;

constexpr size_t MiB = (size_t)1 << 20;
constexpr size_t WS_WL = 26 * MiB;
constexpr size_t WO_IN = 0, WO_OUT = 5 * MiB, WO_UP = 7 * MiB, WO_DN = 18 * MiB, WO_MEM = 24 * MiB;
constexpr size_t WS_GT = 52 * MiB;
constexpr size_t WS_BAR = 52 * MiB + 512 * 1024;
constexpr size_t WS_CT = 53 * MiB;
constexpr size_t WS_PS = 54 * MiB;
constexpr size_t WS_MKV = 60 * MiB;
constexpr size_t WS_XN = 65 * MiB;
constexpr size_t WS_XNM = 226 * MiB;
constexpr size_t WS_Z = 244 * MiB;
constexpr size_t WS_MIX = 644 * MiB;
constexpr size_t WS_G = WS_Z;
constexpr size_t WS_END = 804 * MiB;
static_assert(WS_G + (size_t)MT * DFF * 2 <= WS_END, "G overlay");

__device__ __forceinline__ unsigned cvtpk(float lo, float hi) { f32x2 v = {lo, hi}; bf16x2_t b = __builtin_convertvector(v, bf16x2_t); return __builtin_bit_cast(unsigned, b); }
__device__ __forceinline__ int fresh_tid(int wave) { int z = 0; asm volatile("" : "+v"(z)); return wave * 64 + (int)__builtin_amdgcn_mbcnt_hi(~0u, __builtin_amdgcn_mbcnt_lo(~0u, (unsigned)z)); }
template <int M> __device__ __forceinline__ float xor_get(float v) { return __builtin_bit_cast(float, __builtin_amdgcn_ds_swizzle(__builtin_bit_cast(int, v), 0x1F | (M << 10))); }
template <int M> __device__ __forceinline__ float bfly_add(float v) {
    if (M == 32) { auto rr = __builtin_amdgcn_permlane32_swap(__float_as_uint(v), __float_as_uint(v), false, false); return __uint_as_float(rr[0]) + __uint_as_float(rr[1]); }
    else return v + xor_get<M>(v);
}
template <int M> __device__ __forceinline__ float bfly_max(float v) {
    if (M == 32) { auto rr = __builtin_amdgcn_permlane32_swap(__float_as_uint(v), __float_as_uint(v), false, false); return fmaxf(__uint_as_float(rr[0]), __uint_as_float(rr[1])); }
    else return fmaxf(v, xor_get<M>(v));
}
__device__ __forceinline__ float wave_sum(float v) { v = bfly_add<1>(v); v = bfly_add<2>(v); v = bfly_add<4>(v); v = bfly_add<8>(v); v = bfly_add<16>(v); v = bfly_add<32>(v); return v; }
__device__ __forceinline__ float wave_max(float v) { v = bfly_max<1>(v); v = bfly_max<2>(v); v = bfly_max<4>(v); v = bfly_max<8>(v); v = bfly_max<16>(v); v = bfly_max<32>(v); return v; }
__device__ __forceinline__ float dpp_ror1(float x) { return __builtin_bit_cast(float, __builtin_amdgcn_mov_dpp(__builtin_bit_cast(int, x), 0x121, 0xF, 0xF, true)); }
__device__ __forceinline__ float dpp_ror15(float x) { return __builtin_bit_cast(float, __builtin_amdgcn_mov_dpp(__builtin_bit_cast(int, x), 0x12F, 0xF, 0xF, true)); }

namespace pg8 {
constexpr int BM = 256, BK = 64, HALF = 128, HTB = HALF * BK * 2, STAGE_BYTES = 8 * HTB, NXCD = 8, WGM = 8;
__device__ __forceinline__ int lds_byte(int r, int c) { const int st = (r >> 4) * 2 + (c >> 5), rr = r & 15, cc = c & 31, ob = rr * 64 + cc * 2; return st * 1024 + (ob ^ (((ob >> 9) & 1) << 5)); }
__device__ __forceinline__ void stage_rc(int b, int& R, int& C) { const int st = b / 1024, sb = b % 1024, swz = sb ^ (((sb >> 9) & 1) << 5); R = (st >> 1) * 16 + swz / 64; C = (st & 1) * 32 + (swz % 64) / 2; }
__device__ __forceinline__ int perm32(int rho) { const int n = rho >> 4, i = rho & 15; return 8 * (i >> 2) + 4 * n + (i & 3); }
struct Unit { int pm, pn; };
struct StaticOrder {
    int nM, nN, nwg, G, c;
    __device__ void init(int nM_, int nN_, int G_, int c_) { nM = nM_; nN = nN_; nwg = nM * nN; G = G_; c = c_; }
    __device__ bool next(int i, Unit& u) const {
        const long L = (long)i * G + c; if (L >= nwg) return false;
        int wgid = (int)L; { const int q = nwg / NXCD, r = nwg % NXCD, xcd = wgid % NXCD, off = wgid / NXCD; wgid = (xcd < r ? xcd * (q + 1) : r * (q + 1) + (xcd - r) * q) + off; }
        const int nig = WGM * nN, gid = wgid / nig, fm = gid * WGM, gsz = (nM - fm) < WGM ? (nM - fm) : WGM;
        u.pm = fm + ((wgid % nig) % gsz); u.pn = (wgid % nig) / gsz; return true;
    }
};
__device__ __forceinline__ void halo_decode(int pm, int& seqbase, int& t0, int& slen) {
    if (pm < NBATCH * HT_P) { const int s = pm / HT_P, j = pm - s * HT_P; seqbase = s * SP; t0 = 248 * j; slen = SP; }
    else { const int q = pm - NBATCH * HT_P, s = q / HT_S, j = q - s * HT_S; seqbase = MP + s * SS; t0 = 248 * j; slen = SS; }
}

template <class Epi, bool HALO>
__device__ __forceinline__ void gemm_phase(LAS unsigned char* lds, const bf16_t* Ag, const bf16_t* Btg, const int K, const int nM, const int nN, const int G, const int cidx, const int wave_, const Epi& E) {
    int tid_ = fresh_tid(wave_); asm volatile("" : "+v"(tid_));
    const int tid = tid_, wid = __builtin_amdgcn_readfirstlane(tid >> 6), lane = tid & 63, wr = wid >> 2, wc = wid & 3, fr = lane & 15, fq = lane >> 4;
    const int nt = K / BK;
    StaticOrder S; S.init(nM, nN, G, cidx);
    unsigned voffA[2], voffB[2];
#pragma unroll
    for (int i = 0; i < 2; ++i) { int R, C; stage_rc(tid * 16 + i * 8192, R, C); const int Rb = (R & ~31) + perm32(R & 31);
        const int Ra = HALO ? (R - 2 * (R >> 6)) : R;
        voffA[i] = (unsigned)(Ra * K + C) * 2u; voffB[i] = (unsigned)(Rb * K + C) * 2u; }
    const size_t kstep = (size_t)(BK * 2);
    const size_t hstepB = (size_t)HALF * K * 2;
    const size_t hstepA = HALO ? (size_t)124 * K * 2 : hstepB;
    const unsigned ldsw = (unsigned)wid * 1024u;
    const int aoff = lds_byte(wr * 64 + fr, fq * 8), boff = lds_byte(wc * 32 + fr, fq * 8);
#define PG8_ABASE(pm_) (HALO ? ((const char*)Ag + ((long)halo_row0(pm_)) * (long)K * 2) : ((const char*)Ag + (size_t)(pm_) * 2 * hstepB))
#define PG8_BBASE(pn_) ((const char*)Btg + (size_t)(pn_) * 2 * hstepB)
#define PG8_SA(b, h) (((b) * 2 + (h)) * HTB)
#define PG8_SB(b, h) ((4 + (b) * 2 + (h)) * HTB)
#define PG8_STAGE(bufoff, gbase, voff) do { _Pragma("unroll") for (int _i = 0; _i < 2; ++_i) \
        __builtin_amdgcn_global_load_lds((const unsigned*)((const char*)(gbase) + (voff)[_i]), (LAS unsigned*)(lds + (bufoff) + ldsw + _i * 8192), 16, 0, 0); } while (0)
#define PG8_LDA(dst, b, h) do { _Pragma("unroll") for (int m = 0; m < 4; ++m) _Pragma("unroll") for (int k = 0; k < 2; ++k) dst[m][k] = *(const LAS bf16x8*)(lds + PG8_SA(b, h) + aoff + m * 2048 + k * 1024); } while (0)
#define PG8_LDB(dst, b, h) do { _Pragma("unroll") for (int n = 0; n < 2; ++n) _Pragma("unroll") for (int k = 0; k < 2; ++k) dst[n][k] = *(const LAS bf16x8*)(lds + PG8_SB(b, h) + boff + n * 2048 + k * 1024); } while (0)
#define PG8_MMA(ai, bj, At, Bt) do { __builtin_amdgcn_s_setprio(1); _Pragma("unroll") for (int m = 0; m < 4; ++m) _Pragma("unroll") for (int n = 0; n < 2; ++n) _Pragma("unroll") for (int k = 0; k < 2; ++k) \
        acc[ai][bj][m][n] = __builtin_amdgcn_mfma_f32_16x16x32_bf16(Bt[n][k], At[m][k], acc[ai][bj][m][n], 0, 0, 0); __builtin_amdgcn_s_setprio(0); } while (0)
#define PG8_WAIT_V(n) asm volatile("s_waitcnt vmcnt(" #n ")" ::: "memory")
#define PG8_WAIT_L(n) asm volatile("s_waitcnt lgkmcnt(" #n ")" ::: "memory")
#define PG8_BAR __builtin_amdgcn_s_barrier()
#define PG8_SCHED __builtin_amdgcn_sched_barrier(0)
    auto halo_row0 = [](int pm) -> long { int sb, t0, sl; halo_decode(pm, sb, t0, sl); return (long)sb + t0 - 1; };
    Unit cur, nxt; int ui = 0;
    if (!S.next(0, cur)) return;
    f32x4 acc[2][2][4][2];
#pragma unroll
    for (int a = 0; a < 2; ++a)
#pragma unroll
        for (int b = 0; b < 2; ++b)
#pragma unroll
            for (int m = 0; m < 4; ++m)
#pragma unroll
                for (int n = 0; n < 2; ++n) acc[a][b][m][n] = (f32x4){0.f, 0.f, 0.f, 0.f};
    bf16x8 At[4][2], B0[2][2], B1[2][2];
    const char* cA = PG8_ABASE(cur.pm); const char* cB = PG8_BBASE(cur.pn);
    PG8_STAGE(PG8_SB(0, 0), cB, voffB); PG8_STAGE(PG8_SB(0, 1), cB + hstepB, voffB); PG8_STAGE(PG8_SA(0, 0), cA, voffA); PG8_STAGE(PG8_SA(0, 1), cA + hstepA, voffA);
    if (wr == 1) PG8_BAR;
    PG8_WAIT_V(2); PG8_BAR;
    PG8_STAGE(PG8_SB(1, 0), cB + kstep, voffB); PG8_STAGE(PG8_SA(1, 0), cA + kstep, voffA); PG8_STAGE(PG8_SB(1, 1), cB + hstepB + kstep, voffB);
    PG8_WAIT_V(6); PG8_BAR;
    for (;;) {
        const bool has_next = S.next(ui + 1, nxt);
        const char* nA = has_next ? PG8_ABASE(nxt.pm) : cA; const char* nB = has_next ? PG8_BBASE(nxt.pn) : cB;
        for (int t = 0; t < nt; t += 2) {
            const bool last = (t == nt - 2);
            const char* a1 = cA + (size_t)(t + 1) * kstep;
            const char* a2 = last ? nA : cA + (size_t)(t + 2) * kstep; const char* b2 = last ? nB : cB + (size_t)(t + 2) * kstep;
            const char* a3 = a2 + kstep; const char* b3 = b2 + kstep;
            PG8_LDB(B0, 0, 0); PG8_LDB(B1, 0, 1); PG8_SCHED; PG8_LDA(At, 0, 0); PG8_STAGE(PG8_SA(1, 1), a1 + hstepA, voffA);
            PG8_WAIT_V(8); PG8_WAIT_L(0); PG8_BAR; PG8_MMA(0, 0, At, B0); PG8_MMA(0, 1, At, B1); PG8_BAR; PG8_SCHED;
            PG8_LDA(At, 0, 1); PG8_STAGE(PG8_SB(0, 0), b2, voffB); PG8_STAGE(PG8_SB(0, 1), b2 + hstepB, voffB); PG8_STAGE(PG8_SA(0, 0), a2, voffA);
            PG8_WAIT_V(8); PG8_WAIT_L(0); PG8_BAR; PG8_MMA(1, 0, At, B0); PG8_MMA(1, 1, At, B1); PG8_BAR; PG8_SCHED;
            PG8_LDB(B0, 1, 0); PG8_LDB(B1, 1, 1); PG8_SCHED; PG8_LDA(At, 1, 0); PG8_STAGE(PG8_SA(0, 1), a2 + hstepA, voffA);
            PG8_WAIT_V(8); PG8_WAIT_L(0); PG8_BAR; PG8_MMA(0, 0, At, B0); PG8_MMA(0, 1, At, B1); PG8_BAR; PG8_SCHED;
            PG8_LDA(At, 1, 1); PG8_STAGE(PG8_SB(1, 0), b3, voffB); PG8_STAGE(PG8_SB(1, 1), b3 + hstepB, voffB); PG8_STAGE(PG8_SA(1, 0), a3, voffA);
            PG8_WAIT_V(8); PG8_WAIT_L(0); PG8_BAR; PG8_MMA(1, 0, At, B0); PG8_MMA(1, 1, At, B1); PG8_BAR; PG8_SCHED;
        }
        if (wr == 0) PG8_BAR;
        E(acc, cur, wr, wc, fr, fq);
        if (!has_next) break;
#pragma unroll
        for (int a = 0; a < 2; ++a)
#pragma unroll
            for (int b = 0; b < 2; ++b)
#pragma unroll
                for (int m = 0; m < 4; ++m)
#pragma unroll
                    for (int n = 0; n < 2; ++n) acc[a][b][m][n] = (f32x4){0.f, 0.f, 0.f, 0.f};
        cur = nxt; cA = nA; cB = nB; ++ui;
        if (wr == 1) PG8_BAR;
    }
    PG8_WAIT_V(0);
    PG8_BAR;
#undef PG8_ABASE
#undef PG8_BBASE
#undef PG8_SA
#undef PG8_SB
#undef PG8_STAGE
#undef PG8_LDA
#undef PG8_LDB
#undef PG8_MMA
#undef PG8_WAIT_V
#undef PG8_WAIT_L
#undef PG8_BAR
#undef PG8_SCHED
}

struct EpiZ {
    bf16_t* Z; int ldz; const float* gtab; unsigned normmask; const float* PS;
    __device__ __forceinline__ void operator()(const f32x4 (&acc)[2][2][4][2], const Unit& u, int wr, int wc, int fr, int fq) const {
        const bool nrm = (normmask >> u.pn) & 1u;
        f32x4 gv[2][2];
#pragma unroll
        for (int bj = 0; bj < 2; ++bj)
#pragma unroll
            for (int n = 0; n < 2; ++n) gv[bj][n] = nrm ? *(const f32x4*)(gtab + u.pn * 64 + 32 * bj + 8 * fq + 4 * n) : (f32x4){1.f, 1.f, 1.f, 1.f};
#pragma unroll
        for (int ai = 0; ai < 2; ++ai)
#pragma unroll
            for (int m = 0; m < 4; ++m) {
                const int row = u.pm * BM + ai * HALF + wr * 64 + m * 16 + fr;
                float rs = 1.f;
                if (PS) { const f32x4 p = *(const f32x4*)(PS + (size_t)row * 16 + 4 * fq); float s = (p[0] + p[1]) + (p[2] + p[3]); s = bfly_add<16>(s); s = bfly_add<32>(s); rs = rsqrtf(s * (1.f / DM) + EPS); }
                f32x4 v[2][2]; float ss = 0.f;
#pragma unroll
                for (int bj = 0; bj < 2; ++bj)
#pragma unroll
                    for (int n = 0; n < 2; ++n) { v[bj][n] = acc[ai][bj][m][n] * rs; const f32x4 x = v[bj][n]; ss += (x[0] * x[0] + x[1] * x[1]) + (x[2] * x[2] + x[3] * x[3]); }
                if (nrm) { ss = bfly_add<16>(ss); ss = bfly_add<32>(ss); const float r2 = rsqrtf(ss * (1.f / 64.f) + EPS);
#pragma unroll
                    for (int bj = 0; bj < 2; ++bj)
#pragma unroll
                        for (int n = 0; n < 2; ++n) v[bj][n] = v[bj][n] * r2 * gv[bj][n]; }
                bf16_t* rowp = Z + (size_t)row * ldz + u.pn * BM + 64 * wc + 8 * fq;
#pragma unroll
                for (int bj = 0; bj < 2; ++bj) { u32x4 w; w.x = cvtpk(v[bj][0][0], v[bj][0][1]); w.y = cvtpk(v[bj][0][2], v[bj][0][3]); w.z = cvtpk(v[bj][1][0], v[bj][1][1]); w.w = cvtpk(v[bj][1][2], v[bj][1][3]);
                    *(u32x4*)(rowp + 32 * bj) = w; }
                { asm volatile("" ::: "memory"); __builtin_amdgcn_sched_barrier(0); }
            }
    }
};

struct EpiRes {
    const float* xin_p; const float* xin_s; bf16_t* XR; float* fout; float* PS;
    __device__ __forceinline__ void operator()(const f32x4 (&acc)[2][2][4][2], const Unit& u, int wr, int wc, int fr, int fq) const {
#pragma unroll
        for (int ai = 0; ai < 2; ++ai)
#pragma unroll
            for (int m = 0; m < 4; ++m) {
                const int row = u.pm * BM + ai * HALF + wr * 64 + m * 16 + fr;
                float ss = 0.f;
#pragma unroll
                for (int bj = 0; bj < 2; ++bj) { const int col = u.pn * BM + bj * HALF + wc * 32 + 8 * fq;
                    f32x4 v0, v1;
                    if (xin_p) { const float* xr = (row < MP ? xin_p + (size_t)row * DM : xin_s + (size_t)(row - MP) * DM) + col; v0 = *(const f32x4*)xr; v1 = *(const f32x4*)(xr + 4); }
                    else { const u32x4 w = *(const u32x4*)(XR + (size_t)row * DM + col);
                        v0 = (f32x4){__uint_as_float(w.x << 16), __uint_as_float(w.x & 0xffff0000u), __uint_as_float(w.y << 16), __uint_as_float(w.y & 0xffff0000u)};
                        v1 = (f32x4){__uint_as_float(w.z << 16), __uint_as_float(w.z & 0xffff0000u), __uint_as_float(w.w << 16), __uint_as_float(w.w & 0xffff0000u)}; }
                    v0 = v0 + acc[ai][bj][m][0]; v1 = v1 + acc[ai][bj][m][1];
                    if (fout) { *(f32x4*)(fout + (size_t)row * DM + col) = v0; *(f32x4*)(fout + (size_t)row * DM + col + 4) = v1; }
                    else { u32x4 w; w.x = cvtpk(v0[0], v0[1]); w.y = cvtpk(v0[2], v0[3]); w.z = cvtpk(v1[0], v1[1]); w.w = cvtpk(v1[2], v1[3]); *(u32x4*)(XR + (size_t)row * DM + col) = w; }
                    if (PS) ss += (v0[0] * v0[0] + v0[1] * v0[1]) + (v0[2] * v0[2] + v0[3] * v0[3]) + (v1[0] * v1[0] + v1[1] * v1[1]) + (v1[2] * v1[2] + v1[3] * v1[3]); }
                if (PS) { ss = bfly_add<16>(ss); ss = bfly_add<32>(ss); if (fq == 0) PS[(size_t)row * 16 + 4 * u.pn + wc] = ss; }
                { asm volatile("" ::: "memory"); __builtin_amdgcn_sched_barrier(0); }
            }
    }
};
struct EpiConv {
    bf16_t* Gout; const float* CT; const float* PS;
    __device__ __forceinline__ void operator()(const f32x4 (&acc)[2][2][4][2], const Unit& u, int wr, int wc, int fr, int fq) const {
        int seqbase, t0, slen; halo_decode(u.pm, seqbase, t0, slen);
        const f32x4* ct = (const f32x4*)(CT + (size_t)(128 * u.pn) * 8) + (32 * wc + 8 * fq) * 2;
        const bool f0 = (fr == 0), f15 = (fr == 15);
#pragma unroll
        for (int ai = 0; ai < 2; ++ai) {
            const int tbase = t0 + 62 * (2 * ai + wr) - 1;
            float rs[4];
#pragma unroll
            for (int m = 0; m < 4; ++m) { const int t = tbase + 16 * m + fr; const bool vin = (t >= 0) && (t < slen); const int grow = seqbase + (vin ? t : 0);
                const f32x4 p = *(const f32x4*)(PS + (size_t)grow * 16 + 4 * fq); float s = (p[0] + p[1]) + (p[2] + p[3]); s = bfly_add<16>(s); s = bfly_add<32>(s); rs[m] = vin ? rsqrtf(s * (1.f / DM) + EPS) : 0.f; }
            unsigned outw[4][2][2];
#pragma unroll
            for (int n = 0; n < 2; ++n)
#pragma unroll
                for (int jp = 0; jp < 2; ++jp) {
                    const int cidx = (4 * n + 2 * jp) * 2;
                    const f32x4 c0a = ct[cidx], c0b = ct[cidx + 1], c1a = ct[cidx + 2], c1b = ct[cidx + 3];
                    const f32x2 wv0 = {c0a[0], c1a[0]}, wv1 = {c0a[1], c1a[1]}, wv2 = {c0a[2], c1a[2]}, bv = {c0a[3], c1a[3]};
                    const f32x2 wg0 = {c0b[0], c1b[0]}, wg1 = {c0b[1], c1b[1]}, wg2 = {c0b[2], c1b[2]}, bg = {c0b[3], c1b[3]};
                    f32x2 uv[4], ug[4], cv[4];
#pragma unroll
                    for (int m = 0; m < 4; ++m) { uv[m] = (f32x2){acc[ai][0][m][n][2 * jp], acc[ai][0][m][n][2 * jp + 1]}; ug[m] = (f32x2){acc[ai][1][m][n][2 * jp], acc[ai][1][m][n][2 * jp + 1]}; }
                    asm volatile("" : "+v"(uv[0]), "+v"(uv[1]), "+v"(uv[2]), "+v"(uv[3]), "+v"(ug[0]), "+v"(ug[1]), "+v"(ug[2]), "+v"(ug[3]));
                    {
                        f32x2 rv[4], lv[4];
#pragma unroll
                        for (int m = 0; m < 4; ++m) { uv[m] = uv[m] * rs[m]; rv[m] = (f32x2){dpp_ror1(uv[m][0]), dpp_ror1(uv[m][1])}; lv[m] = (f32x2){dpp_ror15(uv[m][0]), dpp_ror15(uv[m][1])}; }
#pragma unroll
                        for (int m = 0; m < 4; ++m) { const f32x2 pv_ = (m > 0 && f0) ? rv[m > 0 ? m - 1 : 0] : rv[m], nv_ = (m < 3 && f15) ? lv[m < 3 ? m + 1 : 3] : lv[m];
                            cv[m] = bv + wv0 * pv_ + wv1 * uv[m] + wv2 * nv_; }
                    }
                    asm volatile("" : "+v"(cv[0]), "+v"(cv[1]), "+v"(cv[2]), "+v"(cv[3]));
                    {
                        f32x2 rg[4], lg[4];
#pragma unroll
                        for (int m = 0; m < 4; ++m) { ug[m] = ug[m] * rs[m]; rg[m] = (f32x2){dpp_ror1(ug[m][0]), dpp_ror1(ug[m][1])}; lg[m] = (f32x2){dpp_ror15(ug[m][0]), dpp_ror15(ug[m][1])}; }
#pragma unroll
                        for (int m = 0; m < 4; ++m) { const f32x2 pg_ = (m > 0 && f0) ? rg[m > 0 ? m - 1 : 0] : rg[m], ng_ = (m < 3 && f15) ? lg[m < 3 ? m + 1 : 3] : lg[m];
                            const f32x2 cgt = bg + wg0 * pg_ + wg1 * ug[m] + wg2 * ng_;
                            const f32x2 e = cgt * (-LOG2E);
                            const f32x2 d = (f32x2){__builtin_amdgcn_exp2f(e[0]), __builtin_amdgcn_exp2f(e[1])} + 1.f;
                            const f32x2 sg = {__builtin_amdgcn_rcpf(d[0]), __builtin_amdgcn_rcpf(d[1])};
                            const f32x2 ov = cv[m] * cgt * sg;
                            outw[m][n][jp] = cvtpk(ov[0], ov[1]); }
                    }
                    asm volatile("" : "+v"(outw[0][n][jp]), "+v"(outw[1][n][jp]), "+v"(outw[2][n][jp]), "+v"(outw[3][n][jp]) :: "memory"); __builtin_amdgcn_sched_barrier(0);
                }
#pragma unroll
            for (int m = 0; m < 4; ++m) { const int i = 16 * m + fr, t = tbase + i;
                if (i >= 1 && i <= 62 && t < slen) { u32x4 w; w.x = outw[m][0][0]; w.y = outw[m][0][1]; w.z = outw[m][1][0]; w.w = outw[m][1][1];
                    *(u32x4*)(Gout + (size_t)(seqbase + t) * DFF + 128 * u.pn + 32 * wc + 8 * fq) = w; } }
            { asm volatile("" ::: "memory"); __builtin_amdgcn_sched_barrier(0); }
        }
    }
};
}

namespace att {
constexpr int QBLK = 32, KVBLK = 64;
constexpr size_t SHM_V = KVBLK * 128 * 2, SHM_K = KVBLK * 128 * 2;
constexpr int OFF_WS = 65536, OFF_LUTA = 68 * 1024, LUTA_STRIDE = 644, OFF_LUTB = 80 * 1024, OFF_MISC = 112 * 1024;
constexpr float NEG = -1e30f;
#define KSWZ(row, colB) ((row) * 256 + ((colB) ^ (((row) & 7) << 4)))
#define SBAR() __builtin_amdgcn_sched_barrier(0)
__device__ __forceinline__ int crow(int r, int hi) { return (r & 3) + 8 * (r >> 2) + 4 * hi; }
__device__ __forceinline__ void expHalf(f32x16& p0) {
#pragma unroll
    for (int r = 0; r < 16; ++r) p0[r] = __builtin_amdgcn_exp2f(p0[r]);
}
__device__ __forceinline__ void finishSM(f32x16& p0, f32x16& p1, float& l_reg, bf16x8& pa0, bf16x8& pa1, bf16x8& pa2, bf16x8& pa3) {
    float ps = 0;
#pragma unroll
    for (int r = 0; r < 16; ++r) ps += p0[r];
#pragma unroll
    for (int r = 0; r < 16; ++r) ps += p1[r];
    l_reg += ps;
#define PK4(P, BASE, OUT) do { unsigned a0 = cvtpk(P[BASE + 0], P[BASE + 1]), a1 = cvtpk(P[BASE + 2], P[BASE + 3]);   \
    unsigned b0 = cvtpk(P[BASE + 4], P[BASE + 5]), b1 = cvtpk(P[BASE + 6], P[BASE + 7]);                              \
    auto r0 = __builtin_amdgcn_permlane32_swap(a0, b0, false, false); auto r1 = __builtin_amdgcn_permlane32_swap(a1, b1, false, false); \
    u32x4 w = {r0[0], r1[0], r0[1], r1[1]}; OUT = __builtin_bit_cast(bf16x8, w); } while (0)
    PK4(p0, 0, pa0); PK4(p0, 8, pa1); PK4(p1, 0, pa2); PK4(p1, 8, pa3);
#undef PK4
}
__device__ __forceinline__ void qkt(f32x16& p0, f32x16& p1, const char* Ks, const bf16x8* qr, float c0, int r32, int hi, int half) {
#define KFRAG(d0, row) (*reinterpret_cast<const bf16x8*>(Ks + KSWZ((row), (half * 64 + (d0) * 16 + hi * 8) * 2)))
    bf16x8 a0 = KFRAG(0, r32), a1 = KFRAG(0, 32 + r32), b0 = KFRAG(1, r32), b1 = KFRAG(1, 32 + r32);
    SBAR();
#pragma unroll
    for (int r = 0; r < 16; ++r) { p0[r] = c0; p1[r] = c0; }
    SBAR();
    p0 = __builtin_amdgcn_mfma_f32_32x32x16_bf16(a0, qr[0], p0, 0, 0, 0); p1 = __builtin_amdgcn_mfma_f32_32x32x16_bf16(a1, qr[0], p1, 0, 0, 0);
    a0 = KFRAG(2, r32); a1 = KFRAG(2, 32 + r32);
    SBAR();
    p0 = __builtin_amdgcn_mfma_f32_32x32x16_bf16(b0, qr[1], p0, 0, 0, 0); p1 = __builtin_amdgcn_mfma_f32_32x32x16_bf16(b1, qr[1], p1, 0, 0, 0);
    b0 = KFRAG(3, r32); b1 = KFRAG(3, 32 + r32);
    SBAR();
    p0 = __builtin_amdgcn_mfma_f32_32x32x16_bf16(a0, qr[2], p0, 0, 0, 0); p1 = __builtin_amdgcn_mfma_f32_32x32x16_bf16(a1, qr[2], p1, 0, 0, 0);
    p0 = __builtin_amdgcn_mfma_f32_32x32x16_bf16(b0, qr[3], p0, 0, 0, 0); p1 = __builtin_amdgcn_mfma_f32_32x32x16_bf16(b1, qr[3], p1, 0, 0, 0);
#undef KFRAG
}
__device__ __forceinline__ int v_st(int k, int c) { const int kk = (k & ~0xC) | ((k & 4) << 1) | ((k & 8) >> 1); return ((kk >> 3) * 4 + (c >> 5)) * 512 + ((kk & 7) * 32 + (c & 31)) * 2; }
__device__ __forceinline__ int v_rd_base(int lane) { return ((lane & 3) << 3) | (((lane >> 2) & 3) << 6) | (((lane >> 4) & 1) << 5) | (((lane >> 5) & 1) << 8); }
constexpr int v_rd_off(int d0, int ks, int half) { return d0 * 512 + ks * 4096 + half * 2048; }
template <int OFF> __device__ __forceinline__ s16x4 tr_read(int vb) { s16x4 r; asm volatile("ds_read_b64_tr_b16 %0, %1 offset:%2" : "=&v"(r) : "v"(vb), "i"(OFF) : "memory"); return r; }
#define PVLOAD(D0, X) do { X[0] = tr_read<v_rd_off(D0, 0, 0)>(vb); X[1] = tr_read<v_rd_off(D0, 0, 1)>(vb); X[2] = tr_read<v_rd_off(D0, 1, 0)>(vb); X[3] = tr_read<v_rd_off(D0, 1, 1)>(vb); \
    X[4] = tr_read<v_rd_off(D0, 2, 0)>(vb); X[5] = tr_read<v_rd_off(D0, 2, 1)>(vb); X[6] = tr_read<v_rd_off(D0, 3, 0)>(vb); X[7] = tr_read<v_rd_off(D0, 3, 1)>(vb); } while (0)
#define PVPK(L, H) (bf16x8){L[0], L[1], L[2], L[3], H[0], H[1], H[2], H[3]}
#define PVMMA(OD, X) do { OD = __builtin_amdgcn_mfma_f32_32x32x16_bf16(pa0, PVPK(X[0], X[1]), OD, 0, 0, 0); OD = __builtin_amdgcn_mfma_f32_32x32x16_bf16(pa1, PVPK(X[2], X[3]), OD, 0, 0, 0); \
    OD = __builtin_amdgcn_mfma_f32_32x32x16_bf16(pa2, PVPK(X[4], X[5]), OD, 0, 0, 0); OD = __builtin_amdgcn_mfma_f32_32x32x16_bf16(pa3, PVPK(X[6], X[7]), OD, 0, 0, 0); } while (0)
#define PVWAIT() do { asm volatile("s_waitcnt lgkmcnt(0)" ::: "memory"); SBAR(); } while (0)
template <int NB> __device__ __forceinline__ void pv_blocks(f32x16* o, int vb, bf16x8 pa0, bf16x8 pa1, bf16x8 pa2, bf16x8 pa3, f32x16& pe0, f32x16& pe1) {
    s16x4 x[8], y[8];
#define PVEXP(P, B, N) do { _Pragma("unroll") for (int r = (B); r < (B) + (N); ++r) P[r] = __builtin_amdgcn_exp2f(P[r]); } while (0)
    PVLOAD(0, x); PVWAIT();
    if (NB == 4) {
        PVLOAD(1, y); SBAR(); PVMMA(o[0], x); PVEXP(pe0, 0, 8); SBAR(); PVWAIT();
        PVLOAD(2, x); SBAR(); PVMMA(o[1], y); PVEXP(pe0, 8, 8); SBAR(); PVWAIT();
        PVLOAD(3, y); SBAR(); PVMMA(o[2], x); PVEXP(pe1, 0, 8); SBAR(); PVWAIT();
        PVMMA(o[3], y); PVEXP(pe1, 8, 8);
    } else {
        PVLOAD(1, y); SBAR(); PVMMA(o[0], x); PVEXP(pe0, 0, 16); SBAR(); PVWAIT();
        PVMMA(o[1], y); PVEXP(pe1, 0, 16);
    }
#undef PVEXP
}
#undef PVLOAD
#undef PVPK
#undef PVMMA
#undef PVWAIT

struct UnitArgs {
    const bf16_t* Qb;
    const bf16_t* Kb;
    const bf16_t* Vb;
    bf16_t* Ob;
    int ldk;
    int NT;
    int tile0, R;
    int q0;
    int h;
    float farL, farR, lam, oscale;
    float mshift;
    const float* subg;
};

template <int MODE>
__device__ __forceinline__ void attn_unit(const UnitArgs& A, char* lds, const int wave_) {
    int tid_ = fresh_tid(wave_); asm volatile("" : "+v"(tid_));
    const int tid = tid_, wid = __builtin_amdgcn_readfirstlane(tid >> 6), lane = tid & 63, r32 = lane & 31, hi = lane >> 5;
    const int qb = wid & 3, half = wid >> 2;
    if (wid >= 4) __builtin_amdgcn_s_setprio(1);
    char* V_lds = lds; char* K_lds = lds + 2 * SHM_V;
    float* ws = (float*)(lds + OFF_WS) + wid * 64; float* li_l = ws;
    const float* lutA = (const float*)(lds + OFF_LUTA); const float* lutB = (const float*)(lds + OFF_LUTB);
    float l_reg = 0; f32x16 o[4] = {}; bf16x8 qr[4];
    { const bf16_t* Qw = A.Qb + (long)(qb * QBLK + r32) * NZ + half * 64 + hi * 8;
#pragma unroll
      for (int d0 = 0; d0 < 4; ++d0) qr[d0] = *reinterpret_cast<const bf16x8*>(Qw + d0 * 16); }
    const int sr = tid >> 4, sc = (tid & 15) * 8, vst0 = v_st(sr, sc), kst0 = KSWZ(sr, sc * 2);
    const int vbase = (int)(uintptr_t)V_lds + v_rd_base(lane) + (MODE == 0 ? 0 : half * 1024);
    const int ldk = A.ldk; const unsigned ldoff = (unsigned)(sr * ldk + sc) * 2u;
    struct { bf16x8 vs0, vs1, ks0, ks1; } sr_[1];
#define TROW(t) (MODE == 1 ? 64 * ((A.tile0 + (t)) < A.R ? (A.tile0 + (t)) : (A.R - 1)) : 64 * (t))
#define SLOAD(i, t) do { const size_t tb_ = (size_t)TROW(t) * ldk * 2; const char* kb_ = (const char*)A.Kb + tb_; const char* vb_ = (const char*)A.Vb + tb_; const size_t h_ = (size_t)32 * ldk * 2; \
    sr_[i].vs0 = *(const bf16x8*)(vb_ + ldoff); sr_[i].vs1 = *(const bf16x8*)(vb_ + h_ + ldoff); sr_[i].ks0 = *(const bf16x8*)(kb_ + ldoff); sr_[i].ks1 = *(const bf16x8*)(kb_ + h_ + ldoff); } while (0)
#define SWRITE(b, i) do { *(bf16x8*)(V_lds + (b) * (int)SHM_V + vst0) = sr_[i].vs0; *(bf16x8*)(V_lds + (b) * (int)SHM_V + vst0 + 8192) = sr_[i].vs1; \
    *(bf16x8*)(K_lds + (b) * SHM_K + kst0) = sr_[i].ks0; *(bf16x8*)(K_lds + (b) * SHM_K + kst0 + 8192) = sr_[i].ks1; } while (0)
#define SWAIT() asm volatile("s_waitcnt vmcnt(0)" ::: "memory")
    auto zone_of = [&](int t) -> int { const int k0 = 64 * t, qw0 = A.q0 + 32 * qb; return (k0 + 63 - qw0 <= -128) ? 0 : ((k0 - qw0 - 31 >= 128) ? 2 : 1); };
#define QK(P0, P1, KS, t) do { float v_ = -A.mshift; if (MODE == 0) { const int z_ = zone_of(t); v_ += (z_ == 0 ? A.farL : (z_ == 2 ? A.farR : 0.f)); } \
    qkt(P0, P1, KS, qr, v_, r32, hi, half); } while (0)
    auto post = [&](f32x16& p0, f32x16& p1, int t) {
        SBAR();
        if (MODE == 0) {
            if (zone_of(t) == 1) { const int k0 = 64 * t, qw0 = A.q0 + 32 * qb;
                const float* b = lutA + A.h * LUTA_STRIDE + (k0 - qw0 - r32 + 4 * hi + 320);
#pragma unroll
                for (int r = 0; r < 16; ++r) { const int c = (r & 3) + 8 * (r >> 2); p0[r] += b[c]; p1[r] += b[32 + c]; } }
        } else if (MODE == 1) {
            const int kr = A.tile0 + t, rq = A.q0 + (qb >> 1);
            int rs = rq - 4; rs = rs < 0 ? 0 : rs; rs = rs > A.R - 8 ? A.R - 8 : rs;
            if (kr < rs || kr >= rs + 8) {
#pragma unroll
                for (int r = 0; r < 16; ++r) { p0[r] = NEG; p1[r] = NEG; }
            } else {
                const int c = 32 * (qb & 1) + r32; int cs = c - 8; cs = cs < 0 ? 0 : cs; cs = cs > 48 ? 48 : cs;
                const float* b = lutB + ((2 * A.h + half) * 15 + (kr - rq + 7)) * 128 + 64 + 4 * hi - c;
#pragma unroll
                for (int r = 0; r < 16; ++r) { const int cc = (r & 3) + 8 * (r >> 2), j = 4 * hi + cc;
                    p0[r] = ((unsigned)(j - cs) < 16u) ? p0[r] + b[cc] : NEG; p1[r] = ((unsigned)(j + 32 - cs) < 16u) ? p1[r] + b[32 + cc] : NEG; } }
        }
        SBAR();
    };
#define PV(buf, PE0, PE1) pv_blocks<(MODE == 0 ? 4 : 2)>(o, vbase + (buf) * (int)SHM_V, pa0, pa1, pa2, pa3, PE0, PE1)
    f32x16 pA0, pA1, pB0, pB1; bf16x8 pa0, pa1, pa2, pa3; const int NT = A.NT;
    SLOAD(0, 0); asm volatile("s_waitcnt vmcnt(0)" ::: "memory"); SWRITE(0, 0); SLOAD(0, 1); __syncthreads();
    QK(pA0, pA1, K_lds, 0); post(pA0, pA1, 0); expHalf(pA0); expHalf(pA1);
    SWAIT(); SWRITE(1, 0); __syncthreads();
    for (int j = 1; j + 1 < NT; j += 2) {
        SBAR(); QK(pB0, pB1, K_lds + SHM_K, j);
        finishSM(pA0, pA1, l_reg, pa0, pa1, pa2, pa3); SBAR();
        SLOAD(0, j + 1); SBAR();
        post(pB0, pB1, j); PV(0, pB0, pB1);
        __syncthreads(); SWAIT(); SWRITE(0, 0);
        __syncthreads();
        SBAR(); QK(pA0, pA1, K_lds, j + 1);
        finishSM(pB0, pB1, l_reg, pa0, pa1, pa2, pa3); SBAR();
        SLOAD(0, j + 2); SBAR();
        post(pA0, pA1, j + 1); PV(1, pA0, pA1);
        __syncthreads(); SWAIT(); SWRITE(1, 0);
        __syncthreads();
    }
    SBAR(); QK(pB0, pB1, K_lds + SHM_K, NT - 1);
    finishSM(pA0, pA1, l_reg, pa0, pa1, pa2, pa3); SBAR();
    post(pB0, pB1, NT - 1); PV(0, pB0, pB1);
    finishSM(pB0, pB1, l_reg, pa0, pa1, pa2, pa3); SBAR();
    PV(1, pA0, pA1);
    { auto rr = __builtin_amdgcn_permlane32_swap(__float_as_uint(l_reg), __float_as_uint(l_reg), false, false); l_reg = __uint_as_float(rr[0]) + __uint_as_float(rr[1]); }
    if (hi == 0) li_l[r32] = l_reg; asm volatile("s_waitcnt lgkmcnt(0)" ::: "memory");
    float rli[16];
#pragma unroll
    for (int r = 0; r < 16; ++r) rli[r] = __builtin_amdgcn_rcpf(li_l[crow(r, hi)]);
    if (MODE == 0) {
        __syncthreads();
        float* pb = (float*)lds + qb * (32 * 128);
        if (half == 1) {
#pragma unroll
            for (int r = 0; r < 16; ++r)
#pragma unroll
                for (int d0 = 0; d0 < 4; ++d0) pb[crow(r, hi) * 128 + d0 * 32 + r32] = o[d0][r] * rli[r] * A.lam;
        }
        __syncthreads();
        if (half == 0) {
            float ssq[16];
#pragma unroll
            for (int r = 0; r < 16; ++r) { float s = 0.f;
#pragma unroll
                for (int d0 = 0; d0 < 4; ++d0) { const float v = o[d0][r] * rli[r] - pb[crow(r, hi) * 128 + d0 * 32 + r32]; o[d0][r] = v; s += v * v; }
                ssq[r] = s; }
#pragma unroll
            for (int r = 0; r < 16; ++r) { float v = ssq[r]; v = bfly_add<1>(v); v = bfly_add<2>(v); v = bfly_add<4>(v); v = bfly_add<8>(v); v = bfly_add<16>(v); ssq[r] = v; }
            float gv[4];
#pragma unroll
            for (int d0 = 0; d0 < 4; ++d0) gv[d0] = A.subg[d0 * 32 + r32] * A.oscale;
            __hip_bfloat16* Ow = (__hip_bfloat16*)A.Ob + (long)(qb * QBLK) * DM;
#pragma unroll
            for (int r = 0; r < 16; ++r) { const float rn = rsqrtf(ssq[r] * (1.f / 128.f) + EPS); const int orow = crow(r, hi);
#pragma unroll
                for (int d0 = 0; d0 < 4; ++d0) Ow[(long)orow * DM + d0 * 32 + r32] = __float2bfloat16(o[d0][r] * rn * gv[d0]); }
        }
    } else {
        __hip_bfloat16* Ow = (__hip_bfloat16*)A.Ob + (long)(qb * QBLK) * DM + half * 64;
#pragma unroll
        for (int r = 0; r < 16; ++r) { const int orow = crow(r, hi);
#pragma unroll
            for (int d0 = 0; d0 < 2; ++d0) Ow[(long)orow * DM + d0 * 32 + r32] = __float2bfloat16(o[d0][r] * rli[r]); }
    }
    __builtin_amdgcn_s_setprio(0);
    __syncthreads();
#undef TROW
#undef SLOAD
#undef SWRITE
#undef SWAIT
#undef PV
#undef QK
}
#undef KSWZ
#undef SBAR
}

constexpr int LDS_BYTES = 131072 + 1024;
constexpr int OFF_BARST = 131072 + 512;
struct Args { const float* in[27]; float* out; unsigned char* ws; long long pad; };
enum { I_XP = 0, I_XS, I_MEMP, I_MEMS, I_N1G, I_WIN, I_QNA, I_KNA, I_LQ1, I_LK1, I_LQ2, I_LK2, I_SUBG, I_RELB, I_QNB, I_KNB, I_NAB, I_MEMG, I_WMEM, I_QNC, I_KNC, I_WOUT, I_N2G, I_WUP, I_CW, I_CB, I_WDN };

__device__ __forceinline__ void transpose_item(const float* W, int K, int N, bf16_t* WT, int kb, int n0, int src0, LAS float* scr, int lane, const float* gk = nullptr) {
    const int k0 = 64 * kb;
#pragma unroll 8
    for (int i = 0; i < 32; ++i) { const int kk = 2 * i + (lane >> 5); scr[kk * 33 + (lane & 31)] = W[(size_t)(k0 + kk) * N + src0 + (lane & 31)] * (gk ? gk[k0 + kk] : 1.f); }
    asm volatile("s_waitcnt lgkmcnt(0)" ::: "memory");
    const int c = lane & 7;
#pragma unroll
    for (int j = 0; j < 4; ++j) { const int n = (lane >> 3) + 8 * j; const LAS float* s = scr + (8 * c) * 33 + n;
        u32x4 o; o.x = cvtpk(s[0 * 33], s[1 * 33]); o.y = cvtpk(s[2 * 33], s[3 * 33]); o.z = cvtpk(s[4 * 33], s[5 * 33]); o.w = cvtpk(s[6 * 33], s[7 * 33]);
        *(u32x4*)(WT + (size_t)(n0 + n) * K + k0 + 8 * c) = o; }
    asm volatile("s_waitcnt lgkmcnt(0)" ::: "memory");
}
__device__ __forceinline__ int zcol_src(int z) {
    if (z < 1024) { const int base = z < 512 ? 0 : 512, zz = z & 511, h = zz >> 7, s = (zz >> 6) & 1, d = zz & 63; return base + s * 256 + 64 * h + d; }
    return z;
}
__device__ __forceinline__ int ztile_logical(int n0) { const int pn = n0 >> 8, rem = n0 & 255, bj = rem >> 7, wc = (rem >> 5) & 3; return 256 * pn + 64 * wc + 32 * bj; }
__device__ __forceinline__ void rms_row_to_bf16(const float* xrow, const float* g, bf16_t* orow, int lane) {
    const f32x4* xr = (const f32x4*)xrow + lane; const f32x4* gr = (const f32x4*)g + lane;
    f32x4 v[4]; float s = 0.f;
#pragma unroll
    for (int j = 0; j < 4; ++j) { v[j] = xr[64 * j]; s += (v[j][0] * v[j][0] + v[j][1] * v[j][1]) + (v[j][2] * v[j][2] + v[j][3] * v[j][3]); }
    const float rstd = rsqrtf(wave_sum(s) * (1.f / DM) + EPS);
    u32x2* o8 = (u32x2*)orow + lane;
#pragma unroll
    for (int j = 0; j < 4; ++j) { const f32x4 gg = g ? gr[64 * j] : (f32x4){1.f, 1.f, 1.f, 1.f}; u32x2 w; w.x = cvtpk(v[j][0] * rstd * gg[0], v[j][1] * rstd * gg[1]); w.y = cvtpk(v[j][2] * rstd * gg[2], v[j][3] * rstd * gg[3]); o8[64 * j] = w; }
}
__device__ __forceinline__ void rms_row2_to_bf16(const float* xa, const float* xb, const float* g, bf16_t* oa, bf16_t* ob, int lane) {
    const f32x4* ra = (const f32x4*)xa + lane; const f32x4* rb = (const f32x4*)xb + lane; const f32x4* gr = (const f32x4*)g + lane;
    f32x4 va[4], vb[4]; float sa = 0.f, sb = 0.f;
#pragma unroll
    for (int j = 0; j < 4; ++j) { va[j] = ra[64 * j]; vb[j] = rb[64 * j]; }
#pragma unroll
    for (int j = 0; j < 4; ++j) { sa += (va[j][0] * va[j][0] + va[j][1] * va[j][1]) + (va[j][2] * va[j][2] + va[j][3] * va[j][3]); sb += (vb[j][0] * vb[j][0] + vb[j][1] * vb[j][1]) + (vb[j][2] * vb[j][2] + vb[j][3] * vb[j][3]); }
    const float rsa = rsqrtf(wave_sum(sa) * (1.f / DM) + EPS), rsb = rsqrtf(wave_sum(sb) * (1.f / DM) + EPS);
    u32x2* pa = (u32x2*)oa + lane; u32x2* pb = (u32x2*)ob + lane;
#pragma unroll
    for (int j = 0; j < 4; ++j) { const f32x4 gg = g ? gr[64 * j] : (f32x4){1.f, 1.f, 1.f, 1.f}; u32x2 w;
        w.x = cvtpk(va[j][0] * rsa * gg[0], va[j][1] * rsa * gg[1]); w.y = cvtpk(va[j][2] * rsa * gg[2], va[j][3] * rsa * gg[3]); pa[64 * j] = w;
        w.x = cvtpk(vb[j][0] * rsb * gg[0], vb[j][1] * rsb * gg[1]); w.y = cvtpk(vb[j][2] * rsb * gg[2], vb[j][3] * rsb * gg[3]); pb[64 * j] = w; }
}
__device__ __forceinline__ void raw_rows_to_bf16(const float* xa, const float* xb, bf16_t* oa, bf16_t* ob, float* psa, float* psb, int lane, bool two) {
    const f32x4* ra = (const f32x4*)xa + lane; const f32x4* rb = (const f32x4*)xb + lane;
    f32x4 va[4], vb[4]; float sa = 0.f, sb = 0.f;
#pragma unroll
    for (int j = 0; j < 4; ++j) { va[j] = ra[64 * j]; vb[j] = rb[64 * j]; }
#pragma unroll
    for (int j = 0; j < 4; ++j) { sa += (va[j][0] * va[j][0] + va[j][1] * va[j][1]) + (va[j][2] * va[j][2] + va[j][3] * va[j][3]); sb += (vb[j][0] * vb[j][0] + vb[j][1] * vb[j][1]) + (vb[j][2] * vb[j][2] + vb[j][3] * vb[j][3]); }
    sa = wave_sum(sa); sb = wave_sum(sb);
    u32x2* pa = (u32x2*)oa + lane; u32x2* pb = (u32x2*)ob + lane;
#pragma unroll
    for (int j = 0; j < 4; ++j) { u32x2 w; w.x = cvtpk(va[j][0], va[j][1]); w.y = cvtpk(va[j][2], va[j][3]); pa[64 * j] = w;
        if (two) { w.x = cvtpk(vb[j][0], vb[j][1]); w.y = cvtpk(vb[j][2], vb[j][3]); pb[64 * j] = w; } }
    if (lane < 16) { psa[lane] = lane == 0 ? sa : 0.f; if (two) psb[lane] = lane == 0 ? sb : 0.f; }
}
__device__ __forceinline__ int t5_bucket(int rp) {
    const int ret = rp > 0 ? 16 : 0; const int n = rp < 0 ? -rp : rp;
    if (n < 8) return ret + n;
    int v = 8 + (n >= 12) + (n >= 16) + (n >= 23) + (n >= 32) + (n >= 46) + (n >= 64) + (n >= 91);
    return ret + (v > 15 ? 15 : v);
}


typedef unsigned int u32_t;
#define XB_TMO      128
#define XB_XCNT(j)  (256  + 64 * (j))
#define XB_XSUB(j)  (1280 + 64 * (j))
#define XB_XGEN(j)  (2304 + 64 * (j))
#define XB_TOP      3328
#define XB_TOPGEN   3392
#define XCD_BAR_WORDS 3456
#define XB_SPIN_CAP (1u << 22)
__device__ __forceinline__ unsigned xb_ld(unsigned* p)              { return __hip_atomic_load(p, __ATOMIC_RELAXED, __HIP_MEMORY_SCOPE_AGENT); }
__device__ __forceinline__ unsigned xb_add(unsigned* p, unsigned v) { return __hip_atomic_fetch_add(p, v, __ATOMIC_RELAXED, __HIP_MEMORY_SCOPE_AGENT); }
__device__ __forceinline__ unsigned xb_xcc_id() { return (unsigned)__builtin_amdgcn_s_getreg((3 << 11) | 20) & 0xFu; }
#define XB_SPIN(cond, bar) do { unsigned _sp = 0; while (cond) { __builtin_amdgcn_s_sleep(1); \
    if ((++_sp & 255u) == 0u) { if (xb_ld(&(bar)[XB_TMO])) break; if (_sp > XB_SPIN_CAP) { atomicAdd(&(bar)[XB_TMO], 1u); break; } } } } while (0)
struct XcdBarrier { unsigned* bar; unsigned x; volatile LAS unsigned* st; };
__device__ __forceinline__ XcdBarrier xcd_barrier_post(unsigned* bar, volatile LAS unsigned* st, bool t0) {
    XcdBarrier b; b.bar = bar; b.x = xb_xcc_id(); b.st = st;
    if (t0) (void)xb_add(&bar[XB_XCNT(b.x)], 1u);
    return b;
}
__device__ __forceinline__ void xcd_barrier_complete(unsigned* bar, unsigned x, unsigned& nloc, unsigned& nx) {
    const unsigned G = gridDim.x * gridDim.y * gridDim.z;
    unsigned sum, cnt, mine, sp = 0u;
    for (;;) {
        sum = 0u; cnt = 0u; mine = 0u;
#pragma unroll
        for (unsigned j = 0; j < 16; ++j) { const unsigned c = xb_ld(&bar[XB_XCNT(j)]); sum += c; cnt += (c > 0u) ? 1u : 0u; mine = (j == x) ? c : mine; }
        if (sum == G) break;
        __builtin_amdgcn_s_sleep(1);
        if ((++sp & 255u) == 0u) { if (xb_ld(&bar[XB_TMO])) break; if (sp > XB_SPIN_CAP) { atomicAdd(&bar[XB_TMO], 1u); break; } }
    }
    nloc = mine > 0u ? mine : 1u; nx = cnt > 0u ? cnt : 1u;
}
__device__ __forceinline__ void xcd_barrier(const XcdBarrier& b, bool t0) {
    asm volatile("s_waitcnt vmcnt(0)" ::: "memory");
    __syncthreads();
    if (t0) {
        unsigned* bar = b.bar;
        __builtin_amdgcn_s_waitcnt(0);
        unsigned nloc = b.st[0], nx = b.st[1];
        if (nloc == 0u) { xcd_barrier_complete(bar, b.x, nloc, nx); b.st[0] = nloc; b.st[1] = nx; }
        const unsigned old = xb_add(&bar[XB_XSUB(b.x)], 1u);
        const unsigned gen = old / nloc;
        if (old + 1u == (gen + 1u) * nloc) {
            __builtin_amdgcn_fence(__ATOMIC_RELEASE, "agent");
            asm volatile("s_waitcnt vmcnt(0)" ::: "memory");
            const unsigned og = xb_add(&bar[XB_TOP], 1u);
            const unsigned tg = og / nx;
            if (og + 1u == (tg + 1u) * nx) xb_add(&bar[XB_TOPGEN], 1u);
            else XB_SPIN(xb_ld(&bar[XB_TOPGEN]) == tg, bar);
            __builtin_amdgcn_fence(__ATOMIC_ACQUIRE, "agent");
            xb_add(&bar[XB_XGEN(b.x)], 1u);
            asm volatile("s_waitcnt vmcnt(0)" ::: "memory");
        } else {
            XB_SPIN(xb_ld(&bar[XB_XGEN(b.x)]) == gen, bar);
            __builtin_amdgcn_fence(__ATOMIC_ACQUIRE, "agent");
            asm volatile("s_waitcnt vmcnt(0)" ::: "memory");
        }
    }
    __syncthreads();
}

typedef const __attribute__((address_space(4))) struct Args* CArgsP;
#define PHASE_ENV \
    CArgsP ap_ = (CArgsP)__builtin_amdgcn_kernarg_segment_ptr(); asm volatile("" : "+s"(ap_)); \
    unsigned char* ws = ap_->ws; float* out = ap_->out; (void)out; \
    bf16_t* XN = (bf16_t*)(ws + WS_XN); bf16_t* XNM = (bf16_t*)(ws + WS_XNM); bf16_t* Z = (bf16_t*)(ws + WS_Z); bf16_t* MIX = (bf16_t*)(ws + WS_MIX); \
    bf16_t* GB = (bf16_t*)(ws + WS_G); bf16_t* MKV = (bf16_t*)(ws + WS_MKV); float* PS = (float*)(ws + WS_PS); float* GT = (float*)(ws + WS_GT); float* CT = (float*)(ws + WS_CT); \
    (void)XN; (void)XNM; (void)Z; (void)MIX; (void)GB; (void)MKV; (void)PS; (void)GT; (void)CT;

__global__ void __launch_bounds__(NTHREADS, 2) hymba_fwd(Args args) {
    extern __shared__ __attribute__((aligned(16))) unsigned char lds[];
    cg::grid_group grid = cg::this_grid();
    const int tid = threadIdx.x, lane = tid & 63, wave = __builtin_amdgcn_readfirstlane(tid >> 6);
    const int G = gridDim.x, bx = blockIdx.x;
    const int vcu = (G % 8 == 0) ? (bx % 8) * (G / 8) + bx / 8 : bx;
    LAS unsigned char* ldsl = (LAS unsigned char*)lds;
    volatile LAS unsigned* barst = (volatile LAS unsigned*)(ldsl + OFF_BARST);
    if (tid < 2) barst[tid] = 0u;
    __syncthreads();
    { CArgsP ap0 = (CArgsP)__builtin_amdgcn_kernarg_segment_ptr(); (void)xcd_barrier_post((unsigned*)(ap0->ws + WS_BAR), barst, tid == 0); }
#define GRID_BAR() do { CArgsP apb_ = (CArgsP)__builtin_amdgcn_kernarg_segment_ptr(); asm volatile("" : "+s"(apb_)); XcdBarrier b_; b_.bar = (unsigned*)(apb_->ws + WS_BAR); b_.x = xb_xcc_id(); \
        b_.st = (volatile LAS unsigned*)((LAS unsigned char*)lds + OFF_BARST); xcd_barrier(b_, fresh_tid(wave) == 0); } while (0)

    {
        PHASE_ENV
        LAS float* scr = (LAS float*)(ldsl + wave * 16384);
        const int gw = vcu * 8 + wave, NGW = G * 8;
        constexpr int I_IN = 16 * (NZ / 32), I_OUT = 16 * (DM / 32), I_UP = 16 * (NUP / 32), I_DN = (DFF / 64) * (DM / 32), I_MEM = 16 * (512 / 32), I_L = I_IN + I_OUT + I_UP + I_DN + I_MEM;
        for (int it = gw; it < 2 * I_L; it += NGW) {
            const int l = it / I_L; int r = it - l * I_L; unsigned char* wl = ws + l * WS_WL;
            if (r < I_IN) { const int nb = r % (NZ / 32), kb = r / (NZ / 32), n0 = 32 * nb; transpose_item(ap_->in[I_WIN] + (size_t)l * DM * NZ, DM, NZ, (bf16_t*)(wl + WO_IN), kb, n0, zcol_src(ztile_logical(n0)), scr, lane, ap_->in[I_N1G] + l * DM); continue; } r -= I_IN;
            if (r < I_OUT) { const int nb = r % (DM / 32), kb = r / (DM / 32), n0 = 32 * nb; transpose_item(ap_->in[I_WOUT] + (size_t)l * DM * DM, DM, DM, (bf16_t*)(wl + WO_OUT), kb, n0, n0, scr, lane); continue; } r -= I_OUT;
            if (r < I_UP) { const int nb = r % (NUP / 32), kb = r / (NUP / 32), n0 = 32 * nb; const int pn = n0 >> 8, bj = (n0 >> 7) & 1, i0 = n0 & 127;
                transpose_item(ap_->in[I_WUP] + (size_t)l * DM * NUP, DM, NUP, (bf16_t*)(wl + WO_UP), kb, n0, (bj ? DFF : 0) + 128 * pn + i0, scr, lane, ap_->in[I_N2G] + l * DM); continue; } r -= I_UP;
            if (r < I_DN) { const int nb = r % (DM / 32), kb = r / (DM / 32), n0 = 32 * nb; transpose_item(ap_->in[I_WDN] + (size_t)l * DFF * DM, DFF, DM, (bf16_t*)(wl + WO_DN), kb, n0, n0, scr, lane); continue; } r -= I_DN;
            { const int nb = r % (512 / 32), kb = r / (512 / 32), n0 = 32 * nb; transpose_item(ap_->in[I_WMEM] + (size_t)l * DM * 512, DM, 512, (bf16_t*)(wl + WO_MEM), kb, n0, ztile_logical(n0), scr, lane); }
        }
        for (int m = gw; m < MT; m += 2 * NGW) {
            const int m2 = m + NGW;
            const float* xa = m < MP ? ap_->in[I_XP] + (size_t)m * DM : ap_->in[I_XS] + (size_t)(m - MP) * DM;
            const float* xb = m2 < MP ? ap_->in[I_XP] + (size_t)m2 * DM : ap_->in[I_XS] + (size_t)((m2 < MT ? m2 : m) - MP) * DM;
            raw_rows_to_bf16(xa, xb, XN + (size_t)m * DM, XN + (size_t)(m2 < MT ? m2 : m) * DM, PS + (size_t)m * 16, PS + (size_t)(m2 < MT ? m2 : m) * 16, lane, m2 < MT); }
        for (int m = gw; m < 2 * MMEM; m += NGW) { const int l = m / MMEM, r = m - l * MMEM; const float* xr = r < NBATCH * MEMT ? ap_->in[I_MEMP] + (size_t)r * DM : ap_->in[I_MEMS] + (size_t)(r - NBATCH * MEMT) * DM;
            rms_row_to_bf16(xr, ap_->in[I_MEMG] + l * DM, XNM + (size_t)m * DM, lane); }
        for (int i = bx * NTHREADS + tid; i < 2 * DFF; i += G * NTHREADS) { const int l = i / DFF, c = i - l * DFF; const float* w = ap_->in[I_CW] + (size_t)l * 3 * NUP; const float* b = ap_->in[I_CB] + (size_t)l * NUP;
            f32x4 a = {w[c], w[NUP + c], w[2 * NUP + c], b[c]}, g = {w[DFF + c], w[NUP + DFF + c], w[2 * NUP + DFF + c], b[DFF + c]}; *(f32x4*)(CT + (size_t)i * 8) = a; *(f32x4*)(CT + (size_t)i * 8 + 4) = g; }
        if (bx == 0) {
            for (int i = tid; i < 2 * 12 * 64; i += NTHREADS) { const int l = i / 768, t = (i / 64) % 12, d = i & 63; float v = 1.f;
                if (t < 2) v = ap_->in[I_QNA][l * 64 + d] * C2; else if (t < 4) v = ap_->in[I_KNA][l * 64 + d]; else if (t == 6) v = ap_->in[I_QNB][l * 64 + d] * C2; else if (t == 7) v = ap_->in[I_KNB][l * 64 + d];
                else if (t == 9) v = ap_->in[I_QNC][l * 64 + d] * C2; else if (t == 10) v = ap_->in[I_KNC][l * 64 + d];
                GT[i] = v; }
        }
    }
    grid.sync();

#pragma nounroll
    for (int l = 0; l < 2; ++l) {
        {
            PHASE_ENV unsigned char* wl = ws + l * WS_WL;
            pg8::EpiZ E{Z, NZ, GT + l * 768, 0x2CFu, PS};
            pg8::gemm_phase<pg8::EpiZ, false>(ldsl, XN, (const bf16_t*)(wl + WO_IN), DM, MT / 256, NZ / 256, G, bx, wave, E);
            pg8::EpiZ Em{MKV, 512, GT + l * 768 + 640, 0x1u, nullptr};
            pg8::gemm_phase<pg8::EpiZ, false>(ldsl, XNM + (size_t)l * MMEM * DM, (const bf16_t*)(wl + WO_MEM), DM, MMEM / 256, 2, G, bx, wave, Em);
        }
        GRID_BAR();
        {
            PHASE_ENV
            float* lutA = (float*)(lds + att::OFF_LUTA); float* lutB = (float*)(lds + att::OFF_LUTB); float* misc = (float*)(lds + att::OFF_MISC);
            int t2 = fresh_tid(wave); asm volatile("" : "+v"(t2));
            for (int i = t2; i < 4 * 641; i += NTHREADS) { const int h = i / 641, x = i - h * 641; lutA[h * att::LUTA_STRIDE + x] = ap_->in[I_RELB][t5_bucket(x - 320) * 4 + h] * LOG2E; }
            for (int i = t2; i < 4 * 15 * 128; i += NTHREADS) { const int x = i & 127, hd = i >> 7, dc = x - 49; lutB[i] = (dc >= 0 && dc <= 30) ? ap_->in[I_NAB][(size_t)l * 4 * 15 * 31 + hd * 31 + dc] * LOG2E : 0.f; }
            const int lane = t2 & 63;
            if (wave == 0) { const float a = wave_sum(ap_->in[I_LQ1][l * 64 + lane] * ap_->in[I_LK1][l * 64 + lane]), b = wave_sum(ap_->in[I_LQ2][l * 64 + lane] * ap_->in[I_LK2][l * 64 + lane]);
                const float lam_init = 0.8f - 0.6f * expf(-0.3f * (float)l); if (lane == 0) { misc[0] = expf(a) - expf(b) + lam_init; misc[1] = 1.f - lam_init; }
                auto wmax = [&](float v) { return wave_max(fabsf(v)); };
                const float gqa = wmax(ap_->in[I_QNA][l * 64 + lane]), gka = wmax(ap_->in[I_KNA][l * 64 + lane]), gqb = wmax(ap_->in[I_QNB][l * 64 + lane]), gkb = wmax(ap_->in[I_KNB][l * 64 + lane]);
                const float gqc = wmax(ap_->in[I_QNC][l * 64 + lane]), gkc = wmax(ap_->in[I_KNC][l * 64 + lane]);
                const float rbm = wmax(fmaxf(fabsf(ap_->in[I_RELB][lane]), fabsf(ap_->in[I_RELB][64 + lane])));
                float nb = 0.f; for (int i = lane; i < 4 * 15 * 31; i += 64) nb = fmaxf(nb, fabsf(ap_->in[I_NAB][(size_t)l * 4 * 15 * 31 + i])); nb = wmax(nb);
                if (lane == 0) { misc[2] = 1.02f * 64.f * C2 * gqa * gka + rbm * LOG2E; misc[3] = 1.02f * 64.f * C2 * gqb * gkb + nb * LOG2E; misc[4] = 1.02f * 64.f * C2 * gqc * gkc; } }
            __syncthreads();
#define SGPRF(x) __builtin_bit_cast(float, __builtin_amdgcn_readfirstlane(__builtin_bit_cast(int, (float)(x))))
            const float lam = SGPRF(misc[0]), oscale = SGPRF(misc[1]), mshA = SGPRF(misc[2]), mshB = SGPRF(misc[3]), mshC = SGPRF(misc[4]);
            att::UnitArgs U;
            U.subg = ap_->in[I_SUBG] + l * 128; U.lam = lam; U.oscale = oscale; U.tile0 = 0; U.R = 0;
            for (int u = vcu; u < 2560; u += G) {
                int h, qblk, S_; size_t row0;
                if (u < 2048) { const int b = (u & 255) >> 5, c = u & 31, i = u >> 8; h = i >> 1; qblk = (i & 1) * 32 + c; row0 = (size_t)b * SP; S_ = SP; }
                else { const int v = u - 2048, b = (v & 255) >> 5, c = v & 31, idx = (v >> 8) * 32 + c; h = idx >> 4; qblk = idx & 15; row0 = (size_t)MP + (size_t)b * SS; S_ = SS; }
                U.q0 = 128 * qblk; U.h = h; U.NT = S_ / 64; U.ldk = NZ; U.mshift = mshA;
                U.Qb = Z + (row0 + U.q0) * NZ + 128 * h; U.Kb = Z + row0 * NZ + 512 + 128 * h; U.Vb = Z + row0 * NZ + 1024 + 128 * h; U.Ob = MIX + (row0 + U.q0) * DM + 128 * h;
                U.farL = SGPRF(lutA[h * att::LUTA_STRIDE + 0]); U.farR = SGPRF(lutA[h * att::LUTA_STRIDE + 640]);
                att::attn_unit<0>(U, (char*)lds, wave); }
            for (int u = vcu; u < 1280; u += G) {
                int seq, blk, p, R; size_t row0;
                if (u < 1024) { p = u & 1; blk = (u >> 1) & 63; seq = u >> 7; R = SP / GW; row0 = (size_t)seq * SP; }
                else { const int v = u - 1024; p = v & 1; blk = (v >> 1) & 15; seq = v >> 5; R = SS / GW; row0 = (size_t)MP + (size_t)seq * SS; }
                const int r0 = 2 * blk; int lo = r0 - 4; lo = lo < 0 ? 0 : lo; lo = lo > R - 8 ? R - 8 : lo; int hi2 = r0 + 1 - 4; hi2 = hi2 < 0 ? 0 : hi2; hi2 = hi2 > R - 8 ? R - 8 : hi2; hi2 += 7;
                U.q0 = r0; U.h = p; U.tile0 = lo; U.R = R; U.NT = ((hi2 - lo + 1) + 1) & ~1; U.ldk = NZ; U.mshift = mshB;
                U.Qb = Z + (row0 + 128 * blk) * NZ + 1536 + 128 * p; U.Kb = Z + row0 * NZ + 1792 + 128 * p; U.Vb = Z + row0 * NZ + 2048 + 128 * p; U.Ob = MIX + (row0 + 128 * blk) * DM + 512 + 128 * p;
                att::attn_unit<1>(U, (char*)lds, wave); }
            for (int u = vcu; u < 1280; u += G) { const int p = u & 1, blk = u >> 1; const size_t row = (size_t)blk * 128;
                const int mb = row < MP ? (int)(row / SP) : NBATCH + (int)((row - MP) / SS);
                U.NT = MEMT / 64; U.ldk = 512; U.h = p; U.q0 = 0; U.mshift = mshC;
                U.Qb = Z + row * NZ + 2304 + 128 * p; U.Kb = MKV + (size_t)mb * MEMT * 512 + 128 * p; U.Vb = MKV + (size_t)mb * MEMT * 512 + 256 + 128 * p; U.Ob = MIX + row * DM + 768 + 128 * p;
                att::attn_unit<2>(U, (char*)lds, wave); }
        }
        GRID_BAR();
        {
            PHASE_ENV unsigned char* wl = ws + l * WS_WL;
            pg8::EpiRes E{nullptr, nullptr, XN, nullptr, PS};
            pg8::gemm_phase<pg8::EpiRes, false>(ldsl, MIX, (const bf16_t*)(wl + WO_OUT), DM, MT / 256, DM / 256, G, bx, wave, E);
        }
        GRID_BAR();
        {
            PHASE_ENV unsigned char* wl = ws + l * WS_WL;
            pg8::EpiConv E{GB, CT + (size_t)l * DFF * 8, PS};
            pg8::gemm_phase<pg8::EpiConv, true>(ldsl, XN, (const bf16_t*)(wl + WO_UP), DM, NHT, NUP / 256, G, bx, wave, E);
        }
        GRID_BAR();
        {
            PHASE_ENV unsigned char* wl = ws + l * WS_WL;
            pg8::EpiRes E{nullptr, nullptr, XN, l == 1 ? out : nullptr, l == 0 ? PS : nullptr};
            pg8::gemm_phase<pg8::EpiRes, false>(ldsl, GB, (const bf16_t*)(wl + WO_DN), DFF, MT / 256, DM / 256, G, bx, wave, E);
        }
        if (l == 0) GRID_BAR();
    }
}

extern "C" void kernel_launch(void* const* d_in, const int* in_sizes, int n_in, void* d_out, int out_size, void* d_ws, size_t ws_size, hipStream_t stream) {
    static int grid = 0;
    if (grid == 0) {
        if (n_in != 27 || out_size != MT * DM || ws_size < WS_END) { fprintf(stderr, "kernel_launch: unexpected shapes (n_in %d out %d ws %zu)\n", n_in, out_size, ws_size); grid = -1; return; }
        int dev = 0, cus = 0, per_cu = 0;
        hipGetDevice(&dev); hipDeviceGetAttribute(&cus, hipDeviceAttributeMultiprocessorCount, dev);
        if (hipFuncSetAttribute((const void*)hymba_fwd, hipFuncAttributeMaxDynamicSharedMemorySize, LDS_BYTES) != hipSuccess) { fprintf(stderr, "kernel_launch: hipFuncSetAttribute failed\n"); grid = -1; return; }
        if (hipOccupancyMaxActiveBlocksPerMultiprocessor(&per_cu, (const void*)hymba_fwd, NTHREADS, LDS_BYTES) != hipSuccess || per_cu < 1) { fprintf(stderr, "kernel_launch: occupancy query says %d blocks/CU\n", per_cu); per_cu = 1; }
        (void)hipGetLastError();
        grid = cus;
    }
    if (grid < 0) return;
    if (hipMemsetAsync((char*)d_ws + WS_BAR, 0, XCD_BAR_WORDS * 4, stream) != hipSuccess) { fprintf(stderr, "kernel_launch: memset of the barrier words failed\n"); return; }
    Args a{};
    for (int i = 0; i < 27; ++i) a.in[i] = (const float*)d_in[i];
    a.out = (float*)d_out; a.ws = (unsigned char*)d_ws; a.pad = 0;
    void* kargs[] = {&a};
    hipError_t e = hipLaunchCooperativeKernel((const void*)hymba_fwd, dim3(grid), dim3(NTHREADS), kargs, LDS_BYTES, stream);
    if (e != hipSuccess) fprintf(stderr, "kernel_launch: cooperative launch failed: %s (grid %d)\n", hipGetErrorString(e), grid);
}
```

```cpp
#include <hip/hip_runtime.h>
#include <hip/hip_cooperative_groups.h>
#include <hip/hip_bf16.h>
#include <cstdio>
#include <cstdint>
namespace cg = cooperative_groups;

#define LAS __attribute__((address_space(3)))
typedef unsigned short bf16_t;
typedef short bf16x8 __attribute__((ext_vector_type(8)));
typedef short s16x4 __attribute__((ext_vector_type(4)));
typedef float f32x4 __attribute__((ext_vector_type(4)));
typedef float f32x2 __attribute__((ext_vector_type(2)));
typedef float f32x16 __attribute__((ext_vector_type(16)));
typedef unsigned u32x4 __attribute__((ext_vector_type(4)));
typedef unsigned u32x2 __attribute__((ext_vector_type(2)));
typedef __bf16 bf16x2_t __attribute__((ext_vector_type(2)));

constexpr int DM = 1024, NBATCH = 8, SP = 8192, SS = 2048, MP = NBATCH * SP, MS = NBATCH * SS, MT = MP + MS;
constexpr int NZ = 2560, DFF = 2816, NUP = 2 * DFF, MEMT = 256, MMEM = 2 * NBATCH * MEMT;
constexpr int GW = 64;
constexpr float EPS = 1e-6f, LOG2E = 1.4426950408889634f, C2 = 0.125f * LOG2E;
constexpr int NTHREADS = 512;
constexpr int HT_P = 34, HT_S = 9, NHT = NBATCH * HT_P + NBATCH * HT_S;

constexpr size_t MiB = (size_t)1 << 20;
constexpr size_t WS_WL = 26 * MiB;
constexpr size_t WO_IN = 0, WO_OUT = 5 * MiB, WO_UP = 7 * MiB, WO_DN = 18 * MiB, WO_MEM = 24 * MiB;
constexpr size_t WS_GT = 52 * MiB;
constexpr size_t WS_BAR = 52 * MiB + 512 * 1024;
constexpr size_t WS_CT = 53 * MiB;
constexpr size_t WS_PS = 54 * MiB;
constexpr size_t WS_MKV = 60 * MiB;
constexpr size_t WS_XN = 65 * MiB;
constexpr size_t WS_XNM = 226 * MiB;
constexpr size_t WS_Z = 244 * MiB;
constexpr size_t WS_MIX = 644 * MiB;
constexpr size_t WS_G = WS_Z;
constexpr size_t WS_END = 804 * MiB;
static_assert(WS_G + (size_t)MT * DFF * 2 <= WS_END, "G overlay");

__device__ __forceinline__ unsigned cvtpk(float lo, float hi) { f32x2 v = {lo, hi}; bf16x2_t b = __builtin_convertvector(v, bf16x2_t); return __builtin_bit_cast(unsigned, b); }
__device__ __forceinline__ int fresh_tid(int wave) { int z = 0; asm volatile("" : "+v"(z)); return wave * 64 + (int)__builtin_amdgcn_mbcnt_hi(~0u, __builtin_amdgcn_mbcnt_lo(~0u, (unsigned)z)); }
template <int M> __device__ __forceinline__ float xor_get(float v) { return __builtin_bit_cast(float, __builtin_amdgcn_ds_swizzle(__builtin_bit_cast(int, v), 0x1F | (M << 10))); }
template <int M> __device__ __forceinline__ float bfly_add(float v) {
    if (M == 32) { auto rr = __builtin_amdgcn_permlane32_swap(__float_as_uint(v), __float_as_uint(v), false, false); return __uint_as_float(rr[0]) + __uint_as_float(rr[1]); }
    else return v + xor_get<M>(v);
}
template <int M> __device__ __forceinline__ float bfly_max(float v) {
    if (M == 32) { auto rr = __builtin_amdgcn_permlane32_swap(__float_as_uint(v), __float_as_uint(v), false, false); return fmaxf(__uint_as_float(rr[0]), __uint_as_float(rr[1])); }
    else return fmaxf(v, xor_get<M>(v));
}
__device__ __forceinline__ float wave_sum(float v) { v = bfly_add<1>(v); v = bfly_add<2>(v); v = bfly_add<4>(v); v = bfly_add<8>(v); v = bfly_add<16>(v); v = bfly_add<32>(v); return v; }
__device__ __forceinline__ float wave_max(float v) { v = bfly_max<1>(v); v = bfly_max<2>(v); v = bfly_max<4>(v); v = bfly_max<8>(v); v = bfly_max<16>(v); v = bfly_max<32>(v); return v; }
__device__ __forceinline__ float dpp_ror1(float x) { return __builtin_bit_cast(float, __builtin_amdgcn_mov_dpp(__builtin_bit_cast(int, x), 0x121, 0xF, 0xF, true)); }
__device__ __forceinline__ float dpp_ror15(float x) { return __builtin_bit_cast(float, __builtin_amdgcn_mov_dpp(__builtin_bit_cast(int, x), 0x12F, 0xF, 0xF, true)); }

namespace pg8 {
constexpr int BM = 256, BK = 64, HALF = 128, HTB = HALF * BK * 2, STAGE_BYTES = 8 * HTB, NXCD = 8, WGM = 8;
__device__ __forceinline__ int lds_byte(int r, int c) { const int st = (r >> 4) * 2 + (c >> 5), rr = r & 15, cc = c & 31, ob = rr * 64 + cc * 2; return st * 1024 + (ob ^ (((ob >> 9) & 1) << 5)); }
__device__ __forceinline__ void stage_rc(int b, int& R, int& C) { const int st = b / 1024, sb = b % 1024, swz = sb ^ (((sb >> 9) & 1) << 5); R = (st >> 1) * 16 + swz / 64; C = (st & 1) * 32 + (swz % 64) / 2; }
__device__ __forceinline__ int perm32(int rho) { const int n = rho >> 4, i = rho & 15; return 8 * (i >> 2) + 4 * n + (i & 3); }
struct Unit { int pm, pn; };
struct StaticOrder {
    int nM, nN, nwg, G, c;
    __device__ void init(int nM_, int nN_, int G_, int c_) { nM = nM_; nN = nN_; nwg = nM * nN; G = G_; c = c_; }
    __device__ bool next(int i, Unit& u) const {
        const long L = (long)i * G + c; if (L >= nwg) return false;
        int wgid = (int)L; { const int q = nwg / NXCD, r = nwg % NXCD, xcd = wgid % NXCD, off = wgid / NXCD; wgid = (xcd < r ? xcd * (q + 1) : r * (q + 1) + (xcd - r) * q) + off; }
        const int nig = WGM * nN, gid = wgid / nig, fm = gid * WGM, gsz = (nM - fm) < WGM ? (nM - fm) : WGM;
        u.pm = fm + ((wgid % nig) % gsz); u.pn = (wgid % nig) / gsz; return true;
    }
};
__device__ __forceinline__ void halo_decode(int pm, int& seqbase, int& t0, int& slen) {
    if (pm < NBATCH * HT_P) { const int s = pm / HT_P, j = pm - s * HT_P; seqbase = s * SP; t0 = 248 * j; slen = SP; }
    else { const int q = pm - NBATCH * HT_P, s = q / HT_S, j = q - s * HT_S; seqbase = MP + s * SS; t0 = 248 * j; slen = SS; }
}

template <class Epi, bool HALO>
__device__ __forceinline__ void gemm_phase(LAS unsigned char* lds, const bf16_t* Ag, const bf16_t* Btg, const int K, const int nM, const int nN, const int G, const int cidx, const int wave_, const Epi& E) {
    int tid_ = fresh_tid(wave_); asm volatile("" : "+v"(tid_));
    const int tid = tid_, wid = __builtin_amdgcn_readfirstlane(tid >> 6), lane = tid & 63, wr = wid >> 2, wc = wid & 3, fr = lane & 15, fq = lane >> 4;
    const int nt = K / BK;
    StaticOrder S; S.init(nM, nN, G, cidx);
    unsigned voffA[2], voffB[2];
#pragma unroll
    for (int i = 0; i < 2; ++i) { int R, C; stage_rc(tid * 16 + i * 8192, R, C); const int Rb = (R & ~31) + perm32(R & 31);
        const int Ra = HALO ? (R - 2 * (R >> 6)) : R;
        voffA[i] = (unsigned)(Ra * K + C) * 2u; voffB[i] = (unsigned)(Rb * K + C) * 2u; }
    const size_t kstep = (size_t)(BK * 2);
    const size_t hstepB = (size_t)HALF * K * 2;
    const size_t hstepA = HALO ? (size_t)124 * K * 2 : hstepB;
    const unsigned ldsw = (unsigned)wid * 1024u;
    const int aoff = lds_byte(wr * 64 + fr, fq * 8), boff = lds_byte(wc * 32 + fr, fq * 8);
#define PG8_ABASE(pm_) (HALO ? ((const char*)Ag + ((long)halo_row0(pm_)) * (long)K * 2) : ((const char*)Ag + (size_t)(pm_) * 2 * hstepB))
#define PG8_BBASE(pn_) ((const char*)Btg + (size_t)(pn_) * 2 * hstepB)
#define PG8_SA(b, h) (((b) * 2 + (h)) * HTB)
#define PG8_SB(b, h) ((4 + (b) * 2 + (h)) * HTB)
#define PG8_STAGE(bufoff, gbase, voff) do { _Pragma("unroll") for (int _i = 0; _i < 2; ++_i) \
        __builtin_amdgcn_global_load_lds((const unsigned*)((const char*)(gbase) + (voff)[_i]), (LAS unsigned*)(lds + (bufoff) + ldsw + _i * 8192), 16, 0, 0); } while (0)
#define PG8_LDA(dst, b, h) do { _Pragma("unroll") for (int m = 0; m < 4; ++m) _Pragma("unroll") for (int k = 0; k < 2; ++k) dst[m][k] = *(const LAS bf16x8*)(lds + PG8_SA(b, h) + aoff + m * 2048 + k * 1024); } while (0)
#define PG8_LDB(dst, b, h) do { _Pragma("unroll") for (int n = 0; n < 2; ++n) _Pragma("unroll") for (int k = 0; k < 2; ++k) dst[n][k] = *(const LAS bf16x8*)(lds + PG8_SB(b, h) + boff + n * 2048 + k * 1024); } while (0)
#define PG8_MMA(ai, bj, At, Bt) do { __builtin_amdgcn_s_setprio(1); _Pragma("unroll") for (int m = 0; m < 4; ++m) _Pragma("unroll") for (int n = 0; n < 2; ++n) _Pragma("unroll") for (int k = 0; k < 2; ++k) \
        acc[ai][bj][m][n] = __builtin_amdgcn_mfma_f32_16x16x32_bf16(Bt[n][k], At[m][k], acc[ai][bj][m][n], 0, 0, 0); __builtin_amdgcn_s_setprio(0); } while (0)
#define PG8_WAIT_V(n) asm volatile("s_waitcnt vmcnt(" #n ")" ::: "memory")
#define PG8_WAIT_L(n) asm volatile("s_waitcnt lgkmcnt(" #n ")" ::: "memory")
#define PG8_BAR __builtin_amdgcn_s_barrier()
#define PG8_SCHED __builtin_amdgcn_sched_barrier(0)
    auto halo_row0 = [](int pm) -> long { int sb, t0, sl; halo_decode(pm, sb, t0, sl); return (long)sb + t0 - 1; };
    Unit cur, nxt; int ui = 0;
    if (!S.next(0, cur)) return;
    f32x4 acc[2][2][4][2];
#pragma unroll
    for (int a = 0; a < 2; ++a)
#pragma unroll
        for (int b = 0; b < 2; ++b)
#pragma unroll
            for (int m = 0; m < 4; ++m)
#pragma unroll
                for (int n = 0; n < 2; ++n) acc[a][b][m][n] = (f32x4){0.f, 0.f, 0.f, 0.f};
    bf16x8 At[4][2], B0[2][2], B1[2][2];
    const char* cA = PG8_ABASE(cur.pm); const char* cB = PG8_BBASE(cur.pn);
    PG8_STAGE(PG8_SB(0, 0), cB, voffB); PG8_STAGE(PG8_SB(0, 1), cB + hstepB, voffB); PG8_STAGE(PG8_SA(0, 0), cA, voffA); PG8_STAGE(PG8_SA(0, 1), cA + hstepA, voffA);
    if (wr == 1) PG8_BAR;
    PG8_WAIT_V(2); PG8_BAR;
    PG8_STAGE(PG8_SB(1, 0), cB + kstep, voffB); PG8_STAGE(PG8_SA(1, 0), cA + kstep, voffA); PG8_STAGE(PG8_SB(1, 1), cB + hstepB + kstep, voffB);
    PG8_WAIT_V(6); PG8_BAR;
    for (;;) {
        const bool has_next = S.next(ui + 1, nxt);
        const char* nA = has_next ? PG8_ABASE(nxt.pm) : cA; const char* nB = has_next ? PG8_BBASE(nxt.pn) : cB;
        for (int t = 0; t < nt; t += 2) {
            const bool last = (t == nt - 2);
            const char* a1 = cA + (size_t)(t + 1) * kstep;
            const char* a2 = last ? nA : cA + (size_t)(t + 2) * kstep; const char* b2 = last ? nB : cB + (size_t)(t + 2) * kstep;
            const char* a3 = a2 + kstep; const char* b3 = b2 + kstep;
            PG8_LDB(B0, 0, 0); PG8_LDB(B1, 0, 1); PG8_SCHED; PG8_LDA(At, 0, 0); PG8_STAGE(PG8_SA(1, 1), a1 + hstepA, voffA);
            PG8_WAIT_V(8); PG8_WAIT_L(0); PG8_BAR; PG8_MMA(0, 0, At, B0); PG8_MMA(0, 1, At, B1); PG8_BAR; PG8_SCHED;
            PG8_LDA(At, 0, 1); PG8_STAGE(PG8_SB(0, 0), b2, voffB); PG8_STAGE(PG8_SB(0, 1), b2 + hstepB, voffB); PG8_STAGE(PG8_SA(0, 0), a2, voffA);
            PG8_WAIT_V(8); PG8_WAIT_L(0); PG8_BAR; PG8_MMA(1, 0, At, B0); PG8_MMA(1, 1, At, B1); PG8_BAR; PG8_SCHED;
            PG8_LDB(B0, 1, 0); PG8_LDB(B1, 1, 1); PG8_SCHED; PG8_LDA(At, 1, 0); PG8_STAGE(PG8_SA(0, 1), a2 + hstepA, voffA);
            PG8_WAIT_V(8); PG8_WAIT_L(0); PG8_BAR; PG8_MMA(0, 0, At, B0); PG8_MMA(0, 1, At, B1); PG8_BAR; PG8_SCHED;
            PG8_LDA(At, 1, 1); PG8_STAGE(PG8_SB(1, 0), b3, voffB); PG8_STAGE(PG8_SB(1, 1), b3 + hstepB, voffB); PG8_STAGE(PG8_SA(1, 0), a3, voffA);
            PG8_WAIT_V(8); PG8_WAIT_L(0); PG8_BAR; PG8_MMA(1, 0, At, B0); PG8_MMA(1, 1, At, B1); PG8_BAR; PG8_SCHED;
        }
        if (wr == 0) PG8_BAR;
        E(acc, cur, wr, wc, fr, fq);
        if (!has_next) break;
#pragma unroll
        for (int a = 0; a < 2; ++a)
#pragma unroll
            for (int b = 0; b < 2; ++b)
#pragma unroll
                for (int m = 0; m < 4; ++m)
#pragma unroll
                    for (int n = 0; n < 2; ++n) acc[a][b][m][n] = (f32x4){0.f, 0.f, 0.f, 0.f};
        cur = nxt; cA = nA; cB = nB; ++ui;
        if (wr == 1) PG8_BAR;
    }
    PG8_WAIT_V(0);
    PG8_BAR;
#undef PG8_ABASE
#undef PG8_BBASE
#undef PG8_SA
#undef PG8_SB
#undef PG8_STAGE
#undef PG8_LDA
#undef PG8_LDB
#undef PG8_MMA
#undef PG8_WAIT_V
#undef PG8_WAIT_L
#undef PG8_BAR
#undef PG8_SCHED
}

struct EpiZ {
    bf16_t* Z; int ldz; const float* gtab; unsigned normmask; const float* PS;
    __device__ __forceinline__ void operator()(const f32x4 (&acc)[2][2][4][2], const Unit& u, int wr, int wc, int fr, int fq) const {
        const bool nrm = (normmask >> u.pn) & 1u;
        f32x4 gv[2][2];
#pragma unroll
        for (int bj = 0; bj < 2; ++bj)
#pragma unroll
            for (int n = 0; n < 2; ++n) gv[bj][n] = nrm ? *(const f32x4*)(gtab + u.pn * 64 + 32 * bj + 8 * fq + 4 * n) : (f32x4){1.f, 1.f, 1.f, 1.f};
#pragma unroll
        for (int ai = 0; ai < 2; ++ai)
#pragma unroll
            for (int m = 0; m < 4; ++m) {
                const int row = u.pm * BM + ai * HALF + wr * 64 + m * 16 + fr;
                float rs = 1.f;
                if (PS) { const f32x4 p = *(const f32x4*)(PS + (size_t)row * 16 + 4 * fq); float s = (p[0] + p[1]) + (p[2] + p[3]); s = bfly_add<16>(s); s = bfly_add<32>(s); rs = rsqrtf(s * (1.f / DM) + EPS); }
                f32x4 v[2][2]; float ss = 0.f;
#pragma unroll
                for (int bj = 0; bj < 2; ++bj)
#pragma unroll
                    for (int n = 0; n < 2; ++n) { v[bj][n] = acc[ai][bj][m][n] * rs; const f32x4 x = v[bj][n]; ss += (x[0] * x[0] + x[1] * x[1]) + (x[2] * x[2] + x[3] * x[3]); }
                if (nrm) { ss = bfly_add<16>(ss); ss = bfly_add<32>(ss); const float r2 = rsqrtf(ss * (1.f / 64.f) + EPS);
#pragma unroll
                    for (int bj = 0; bj < 2; ++bj)
#pragma unroll
                        for (int n = 0; n < 2; ++n) v[bj][n] = v[bj][n] * r2 * gv[bj][n]; }
                bf16_t* rowp = Z + (size_t)row * ldz + u.pn * BM + 64 * wc + 8 * fq;
#pragma unroll
                for (int bj = 0; bj < 2; ++bj) { u32x4 w; w.x = cvtpk(v[bj][0][0], v[bj][0][1]); w.y = cvtpk(v[bj][0][2], v[bj][0][3]); w.z = cvtpk(v[bj][1][0], v[bj][1][1]); w.w = cvtpk(v[bj][1][2], v[bj][1][3]);
                    *(u32x4*)(rowp + 32 * bj) = w; }
                { asm volatile("" ::: "memory"); __builtin_amdgcn_sched_barrier(0); }
            }
    }
};

struct EpiRes {
    const float* xin_p; const float* xin_s; bf16_t* XR; float* fout; float* PS;
    __device__ __forceinline__ void operator()(const f32x4 (&acc)[2][2][4][2], const Unit& u, int wr, int wc, int fr, int fq) const {
#pragma unroll
        for (int ai = 0; ai < 2; ++ai)
#pragma unroll
            for (int m = 0; m < 4; ++m) {
                const int row = u.pm * BM + ai * HALF + wr * 64 + m * 16 + fr;
                float ss = 0.f;
#pragma unroll
                for (int bj = 0; bj < 2; ++bj) { const int col = u.pn * BM + bj * HALF + wc * 32 + 8 * fq;
                    f32x4 v0, v1;
                    if (xin_p) { const float* xr = (row < MP ? xin_p + (size_t)row * DM : xin_s + (size_t)(row - MP) * DM) + col; v0 = *(const f32x4*)xr; v1 = *(const f32x4*)(xr + 4); }
                    else { const u32x4 w = *(const u32x4*)(XR + (size_t)row * DM + col);
                        v0 = (f32x4){__uint_as_float(w.x << 16), __uint_as_float(w.x & 0xffff0000u), __uint_as_float(w.y << 16), __uint_as_float(w.y & 0xffff0000u)};
                        v1 = (f32x4){__uint_as_float(w.z << 16), __uint_as_float(w.z & 0xffff0000u), __uint_as_float(w.w << 16), __uint_as_float(w.w & 0xffff0000u)}; }
                    v0 = v0 + acc[ai][bj][m][0]; v1 = v1 + acc[ai][bj][m][1];
                    if (fout) { *(f32x4*)(fout + (size_t)row * DM + col) = v0; *(f32x4*)(fout + (size_t)row * DM + col + 4) = v1; }
                    else { u32x4 w; w.x = cvtpk(v0[0], v0[1]); w.y = cvtpk(v0[2], v0[3]); w.z = cvtpk(v1[0], v1[1]); w.w = cvtpk(v1[2], v1[3]); *(u32x4*)(XR + (size_t)row * DM + col) = w; }
                    if (PS) ss += (v0[0] * v0[0] + v0[1] * v0[1]) + (v0[2] * v0[2] + v0[3] * v0[3]) + (v1[0] * v1[0] + v1[1] * v1[1]) + (v1[2] * v1[2] + v1[3] * v1[3]); }
                if (PS) { ss = bfly_add<16>(ss); ss = bfly_add<32>(ss); if (fq == 0) PS[(size_t)row * 16 + 4 * u.pn + wc] = ss; }
                { asm volatile("" ::: "memory"); __builtin_amdgcn_sched_barrier(0); }
            }
    }
};
struct EpiConv {
    bf16_t* Gout; const float* CT; const float* PS;
    __device__ __forceinline__ void operator()(const f32x4 (&acc)[2][2][4][2], const Unit& u, int wr, int wc, int fr, int fq) const {
        int seqbase, t0, slen; halo_decode(u.pm, seqbase, t0, slen);
        const f32x4* ct = (const f32x4*)(CT + (size_t)(128 * u.pn) * 8) + (32 * wc + 8 * fq) * 2;
        const bool f0 = (fr == 0), f15 = (fr == 15);
#pragma unroll
        for (int ai = 0; ai < 2; ++ai) {
            const int tbase = t0 + 62 * (2 * ai + wr) - 1;
            float rs[4];
#pragma unroll
            for (int m = 0; m < 4; ++m) { const int t = tbase + 16 * m + fr; const bool vin = (t >= 0) && (t < slen); const int grow = seqbase + (vin ? t : 0);
                const f32x4 p = *(const f32x4*)(PS + (size_t)grow * 16 + 4 * fq); float s = (p[0] + p[1]) + (p[2] + p[3]); s = bfly_add<16>(s); s = bfly_add<32>(s); rs[m] = vin ? rsqrtf(s * (1.f / DM) + EPS) : 0.f; }
            unsigned outw[4][2][2];
#pragma unroll
            for (int n = 0; n < 2; ++n)
#pragma unroll
                for (int jp = 0; jp < 2; ++jp) {
                    const int cidx = (4 * n + 2 * jp) * 2;
                    const f32x4 c0a = ct[cidx], c0b = ct[cidx + 1], c1a = ct[cidx + 2], c1b = ct[cidx + 3];
                    const f32x2 wv0 = {c0a[0], c1a[0]}, wv1 = {c0a[1], c1a[1]}, wv2 = {c0a[2], c1a[2]}, bv = {c0a[3], c1a[3]};
                    const f32x2 wg0 = {c0b[0], c1b[0]}, wg1 = {c0b[1], c1b[1]}, wg2 = {c0b[2], c1b[2]}, bg = {c0b[3], c1b[3]};
                    f32x2 uv[4], ug[4], cv[4];
#pragma unroll
                    for (int m = 0; m < 4; ++m) { uv[m] = (f32x2){acc[ai][0][m][n][2 * jp], acc[ai][0][m][n][2 * jp + 1]}; ug[m] = (f32x2){acc[ai][1][m][n][2 * jp], acc[ai][1][m][n][2 * jp + 1]}; }
                    asm volatile("" : "+v"(uv[0]), "+v"(uv[1]), "+v"(uv[2]), "+v"(uv[3]), "+v"(ug[0]), "+v"(ug[1]), "+v"(ug[2]), "+v"(ug[3]));
                    {
                        f32x2 rv[4], lv[4];
#pragma unroll
                        for (int m = 0; m < 4; ++m) { uv[m] = uv[m] * rs[m]; rv[m] = (f32x2){dpp_ror1(uv[m][0]), dpp_ror1(uv[m][1])}; lv[m] = (f32x2){dpp_ror15(uv[m][0]), dpp_ror15(uv[m][1])}; }
#pragma unroll
                        for (int m = 0; m < 4; ++m) { const f32x2 pv_ = (m > 0 && f0) ? rv[m > 0 ? m - 1 : 0] : rv[m], nv_ = (m < 3 && f15) ? lv[m < 3 ? m + 1 : 3] : lv[m];
                            cv[m] = bv + wv0 * pv_ + wv1 * uv[m] + wv2 * nv_; }
                    }
                    asm volatile("" : "+v"(cv[0]), "+v"(cv[1]), "+v"(cv[2]), "+v"(cv[3]));
                    {
                        f32x2 rg[4], lg[4];
#pragma unroll
                        for (int m = 0; m < 4; ++m) { ug[m] = ug[m] * rs[m]; rg[m] = (f32x2){dpp_ror1(ug[m][0]), dpp_ror1(ug[m][1])}; lg[m] = (f32x2){dpp_ror15(ug[m][0]), dpp_ror15(ug[m][1])}; }
#pragma unroll
                        for (int m = 0; m < 4; ++m) { const f32x2 pg_ = (m > 0 && f0) ? rg[m > 0 ? m - 1 : 0] : rg[m], ng_ = (m < 3 && f15) ? lg[m < 3 ? m + 1 : 3] : lg[m];
                            const f32x2 cgt = bg + wg0 * pg_ + wg1 * ug[m] + wg2 * ng_;
                            const f32x2 e = cgt * (-LOG2E);
                            const f32x2 d = (f32x2){__builtin_amdgcn_exp2f(e[0]), __builtin_amdgcn_exp2f(e[1])} + 1.f;
                            const f32x2 sg = {__builtin_amdgcn_rcpf(d[0]), __builtin_amdgcn_rcpf(d[1])};
                            const f32x2 ov = cv[m] * cgt * sg;
                            outw[m][n][jp] = cvtpk(ov[0], ov[1]); }
                    }
                    asm volatile("" : "+v"(outw[0][n][jp]), "+v"(outw[1][n][jp]), "+v"(outw[2][n][jp]), "+v"(outw[3][n][jp]) :: "memory"); __builtin_amdgcn_sched_barrier(0);
                }
#pragma unroll
            for (int m = 0; m < 4; ++m) { const int i = 16 * m + fr, t = tbase + i;
                if (i >= 1 && i <= 62 && t < slen) { u32x4 w; w.x = outw[m][0][0]; w.y = outw[m][0][1]; w.z = outw[m][1][0]; w.w = outw[m][1][1];
                    *(u32x4*)(Gout + (size_t)(seqbase + t) * DFF + 128 * u.pn + 32 * wc + 8 * fq) = w; } }
            { asm volatile("" ::: "memory"); __builtin_amdgcn_sched_barrier(0); }
        }
    }
};
}

namespace att {
constexpr int QBLK = 32, KVBLK = 64;
constexpr size_t SHM_V = KVBLK * 128 * 2, SHM_K = KVBLK * 128 * 2;
constexpr int OFF_WS = 65536, OFF_LUTA = 68 * 1024, LUTA_STRIDE = 644, OFF_LUTB = 80 * 1024, OFF_MISC = 112 * 1024;
constexpr float NEG = -1e30f;
#define KSWZ(row, colB) ((row) * 256 + ((colB) ^ (((row) & 7) << 4)))
#define SBAR() __builtin_amdgcn_sched_barrier(0)
__device__ __forceinline__ int crow(int r, int hi) { return (r & 3) + 8 * (r >> 2) + 4 * hi; }
__device__ __forceinline__ void expHalf(f32x16& p0) {
#pragma unroll
    for (int r = 0; r < 16; ++r) p0[r] = __builtin_amdgcn_exp2f(p0[r]);
}
__device__ __forceinline__ void finishSM(f32x16& p0, f32x16& p1, float& l_reg, bf16x8& pa0, bf16x8& pa1, bf16x8& pa2, bf16x8& pa3) {
    float ps = 0;
#pragma unroll
    for (int r = 0; r < 16; ++r) ps += p0[r];
#pragma unroll
    for (int r = 0; r < 16; ++r) ps += p1[r];
    l_reg += ps;
#define PK4(P, BASE, OUT) do { unsigned a0 = cvtpk(P[BASE + 0], P[BASE + 1]), a1 = cvtpk(P[BASE + 2], P[BASE + 3]);   \
    unsigned b0 = cvtpk(P[BASE + 4], P[BASE + 5]), b1 = cvtpk(P[BASE + 6], P[BASE + 7]);                              \
    auto r0 = __builtin_amdgcn_permlane32_swap(a0, b0, false, false); auto r1 = __builtin_amdgcn_permlane32_swap(a1, b1, false, false); \
    u32x4 w = {r0[0], r1[0], r0[1], r1[1]}; OUT = __builtin_bit_cast(bf16x8, w); } while (0)
    PK4(p0, 0, pa0); PK4(p0, 8, pa1); PK4(p1, 0, pa2); PK4(p1, 8, pa3);
#undef PK4
}
__device__ __forceinline__ void qkt(f32x16& p0, f32x16& p1, const char* Ks, const bf16x8* qr, float c0, int r32, int hi, int half) {
#define KFRAG(d0, row) (*reinterpret_cast<const bf16x8*>(Ks + KSWZ((row), (half * 64 + (d0) * 16 + hi * 8) * 2)))
    bf16x8 a0 = KFRAG(0, r32), a1 = KFRAG(0, 32 + r32), b0 = KFRAG(1, r32), b1 = KFRAG(1, 32 + r32);
    SBAR();
#pragma unroll
    for (int r = 0; r < 16; ++r) { p0[r] = c0; p1[r] = c0; }
    SBAR();
    p0 = __builtin_amdgcn_mfma_f32_32x32x16_bf16(a0, qr[0], p0, 0, 0, 0); p1 = __builtin_amdgcn_mfma_f32_32x32x16_bf16(a1, qr[0], p1, 0, 0, 0);
    a0 = KFRAG(2, r32); a1 = KFRAG(2, 32 + r32);
    SBAR();
    p0 = __builtin_amdgcn_mfma_f32_32x32x16_bf16(b0, qr[1], p0, 0, 0, 0); p1 = __builtin_amdgcn_mfma_f32_32x32x16_bf16(b1, qr[1], p1, 0, 0, 0);
    b0 = KFRAG(3, r32); b1 = KFRAG(3, 32 + r32);
    SBAR();
    p0 = __builtin_amdgcn_mfma_f32_32x32x16_bf16(a0, qr[2], p0, 0, 0, 0); p1 = __builtin_amdgcn_mfma_f32_32x32x16_bf16(a1, qr[2], p1, 0, 0, 0);
    p0 = __builtin_amdgcn_mfma_f32_32x32x16_bf16(b0, qr[3], p0, 0, 0, 0); p1 = __builtin_amdgcn_mfma_f32_32x32x16_bf16(b1, qr[3], p1, 0, 0, 0);
#undef KFRAG
}
__device__ __forceinline__ int v_st(int k, int c) { const int kk = (k & ~0xC) | ((k & 4) << 1) | ((k & 8) >> 1); return ((kk >> 3) * 4 + (c >> 5)) * 512 + ((kk & 7) * 32 + (c & 31)) * 2; }
__device__ __forceinline__ int v_rd_base(int lane) { return ((lane & 3) << 3) | (((lane >> 2) & 3) << 6) | (((lane >> 4) & 1) << 5) | (((lane >> 5) & 1) << 8); }
constexpr int v_rd_off(int d0, int ks, int half) { return d0 * 512 + ks * 4096 + half * 2048; }
template <int OFF> __device__ __forceinline__ s16x4 tr_read(int vb) { s16x4 r; asm volatile("ds_read_b64_tr_b16 %0, %1 offset:%2" : "=&v"(r) : "v"(vb), "i"(OFF) : "memory"); return r; }
#define PVLOAD(D0, X) do { X[0] = tr_read<v_rd_off(D0, 0, 0)>(vb); X[1] = tr_read<v_rd_off(D0, 0, 1)>(vb); X[2] = tr_read<v_rd_off(D0, 1, 0)>(vb); X[3] = tr_read<v_rd_off(D0, 1, 1)>(vb); \
    X[4] = tr_read<v_rd_off(D0, 2, 0)>(vb); X[5] = tr_read<v_rd_off(D0, 2, 1)>(vb); X[6] = tr_read<v_rd_off(D0, 3, 0)>(vb); X[7] = tr_read<v_rd_off(D0, 3, 1)>(vb); } while (0)
#define PVPK(L, H) (bf16x8){L[0], L[1], L[2], L[3], H[0], H[1], H[2], H[3]}
#define PVMMA(OD, X) do { OD = __builtin_amdgcn_mfma_f32_32x32x16_bf16(pa0, PVPK(X[0], X[1]), OD, 0, 0, 0); OD = __builtin_amdgcn_mfma_f32_32x32x16_bf16(pa1, PVPK(X[2], X[3]), OD, 0, 0, 0); \
    OD = __builtin_amdgcn_mfma_f32_32x32x16_bf16(pa2, PVPK(X[4], X[5]), OD, 0, 0, 0); OD = __builtin_amdgcn_mfma_f32_32x32x16_bf16(pa3, PVPK(X[6], X[7]), OD, 0, 0, 0); } while (0)
#define PVWAIT() do { asm volatile("s_waitcnt lgkmcnt(0)" ::: "memory"); SBAR(); } while (0)
template <int NB> __device__ __forceinline__ void pv_blocks(f32x16* o, int vb, bf16x8 pa0, bf16x8 pa1, bf16x8 pa2, bf16x8 pa3, f32x16& pe0, f32x16& pe1) {
    s16x4 x[8], y[8];
#define PVEXP(P, B, N) do { _Pragma("unroll") for (int r = (B); r < (B) + (N); ++r) P[r] = __builtin_amdgcn_exp2f(P[r]); } while (0)
    PVLOAD(0, x); PVWAIT();
    if (NB == 4) {
        PVLOAD(1, y); SBAR(); PVMMA(o[0], x); PVEXP(pe0, 0, 8); SBAR(); PVWAIT();
        PVLOAD(2, x); SBAR(); PVMMA(o[1], y); PVEXP(pe0, 8, 8); SBAR(); PVWAIT();
        PVLOAD(3, y); SBAR(); PVMMA(o[2], x); PVEXP(pe1, 0, 8); SBAR(); PVWAIT();
        PVMMA(o[3], y); PVEXP(pe1, 8, 8);
    } else {
        PVLOAD(1, y); SBAR(); PVMMA(o[0], x); PVEXP(pe0, 0, 16); SBAR(); PVWAIT();
        PVMMA(o[1], y); PVEXP(pe1, 0, 16);
    }
#undef PVEXP
}
#undef PVLOAD
#undef PVPK
#undef PVMMA
#undef PVWAIT

__device__ __forceinline__ void glds16(const void* gsrc, unsigned lds_dst) { unsigned keep;
    asm volatile("s_mov_b32 %0, m0\n\ts_mov_b32 m0, %2\n\ts_nop 0\n\tglobal_load_lds_dwordx4 %1, off\n\ts_mov_b32 m0, %0" : "=&s"(keep) : "v"(gsrc), "s"(lds_dst) : "memory"); }

struct UnitArgs {
    const bf16_t* Qb;
    const bf16_t* Kb;
    const bf16_t* Vb;
    bf16_t* Ob;
    int ldk;
    int NT;
    int tile0, R;
    int q0;
    int h;
    float farL, farR, lam, oscale;
    float mshift;
    const float* subg;
};

template <int MODE>
__device__ __forceinline__ void attn_unit(const UnitArgs& A, char* lds, const int wave_) {
    int tid_ = fresh_tid(wave_); asm volatile("" : "+v"(tid_));
    const int tid = tid_, wid = __builtin_amdgcn_readfirstlane(tid >> 6), lane = tid & 63, r32 = lane & 31, hi = lane >> 5;
    const int qb = wid & 3, half = wid >> 2;
    if (wid >= 4) __builtin_amdgcn_s_setprio(1);
    char* V_lds = lds; char* K_lds = lds + 2 * SHM_V;
    float* ws = (float*)(lds + OFF_WS) + wid * 64; float* li_l = ws;
    const float* lutA = (const float*)(lds + OFF_LUTA); const float* lutB = (const float*)(lds + OFF_LUTB);
    float l_reg = 0; f32x16 o[4] = {}; bf16x8 qr[4];
    { const bf16_t* Qw = A.Qb + (long)(qb * QBLK + r32) * NZ + half * 64 + hi * 8;
#pragma unroll
      for (int d0 = 0; d0 < 4; ++d0) qr[d0] = *reinterpret_cast<const bf16x8*>(Qw + d0 * 16); }
    const int sr = tid >> 4, sc = (tid & 15) * 8, vst0 = v_st(sr, sc);
    const int vbase = (int)(uintptr_t)V_lds + v_rd_base(lane) + (MODE == 0 ? 0 : half * 1024);
    const int ldk = A.ldk; const unsigned ldoff = (unsigned)(sr * ldk + sc) * 2u;
    struct { bf16x8 vs0, vs1; } sr_[1];
    const unsigned kdoff = (unsigned)(sr * ldk + (((tid & 15) ^ (sr & 7)) * 8)) * 2u;
    const unsigned kdst0 = (unsigned)__builtin_amdgcn_readfirstlane((int)((unsigned)(uintptr_t)K_lds + (unsigned)wid * 1024u));
#define TROW(t) (MODE == 1 ? 64 * ((A.tile0 + (t)) < A.R ? (A.tile0 + (t)) : (A.R - 1)) : 64 * (t))
#define SLOAD(i, t) do { const size_t tb_ = (size_t)TROW(t) * ldk * 2; const char* kb_ = (const char*)A.Kb + tb_; const char* vb_ = (const char*)A.Vb + tb_; const size_t h_ = (size_t)32 * ldk * 2; \
    sr_[i].vs0 = *(const bf16x8*)(vb_ + ldoff); sr_[i].vs1 = *(const bf16x8*)(vb_ + h_ + ldoff); \
    const unsigned kd_ = kdst0 + (unsigned)(((t) & 1) * (int)SHM_K); glds16(kb_ + kdoff, kd_); glds16(kb_ + h_ + kdoff, kd_ + 8192u); } while (0)
#define SWRITE(b, i) do { *(bf16x8*)(V_lds + (b) * (int)SHM_V + vst0) = sr_[i].vs0; *(bf16x8*)(V_lds + (b) * (int)SHM_V + vst0 + 8192) = sr_[i].vs1; } while (0)
#define SWAIT() asm volatile("s_waitcnt vmcnt(0)" ::: "memory")
    auto zone_of = [&](int t) -> int { const int k0 = 64 * t, qw0 = A.q0 + 32 * qb; return (k0 + 63 - qw0 <= -128) ? 0 : ((k0 - qw0 - 31 >= 128) ? 2 : 1); };
#define QK(P0, P1, KS, t) do { float v_ = -A.mshift; if (MODE == 0) { const int z_ = zone_of(t); v_ += (z_ == 0 ? A.farL : (z_ == 2 ? A.farR : 0.f)); } \
    qkt(P0, P1, KS, qr, v_, r32, hi, half); } while (0)
    auto post = [&](f32x16& p0, f32x16& p1, int t) {
        SBAR();
        if (MODE == 0) {
            if (zone_of(t) == 1) { const int k0 = 64 * t, qw0 = A.q0 + 32 * qb;
                const float* b = lutA + A.h * LUTA_STRIDE + (k0 - qw0 - r32 + 4 * hi + 320);
#pragma unroll
                for (int r = 0; r < 16; ++r) { const int c = (r & 3) + 8 * (r >> 2); p0[r] += b[c]; p1[r] += b[32 + c]; } }
        } else if (MODE == 1) {
            const int kr = A.tile0 + t, rq = A.q0 + (qb >> 1);
            int rs = rq - 4; rs = rs < 0 ? 0 : rs; rs = rs > A.R - 8 ? A.R - 8 : rs;
            if (kr < rs || kr >= rs + 8) {
#pragma unroll
                for (int r = 0; r < 16; ++r) { p0[r] = NEG; p1[r] = NEG; }
            } else {
                const int c = 32 * (qb & 1) + r32; int cs = c - 8; cs = cs < 0 ? 0 : cs; cs = cs > 48 ? 48 : cs;
                const float* b = lutB + ((2 * A.h + half) * 15 + (kr - rq + 7)) * 128 + 64 + 4 * hi - c;
#pragma unroll
                for (int r = 0; r < 16; ++r) { const int cc = (r & 3) + 8 * (r >> 2), j = 4 * hi + cc;
                    p0[r] = ((unsigned)(j - cs) < 16u) ? p0[r] + b[cc] : NEG; p1[r] = ((unsigned)(j + 32 - cs) < 16u) ? p1[r] + b[32 + cc] : NEG; } }
        }
        SBAR();
    };
#define PV(buf, PE0, PE1) pv_blocks<(MODE == 0 ? 4 : 2)>(o, vbase + (buf) * (int)SHM_V, pa0, pa1, pa2, pa3, PE0, PE1)
    f32x16 pA0, pA1, pB0, pB1; bf16x8 pa0, pa1, pa2, pa3; const int NT = A.NT;
    SLOAD(0, 0); asm volatile("s_waitcnt vmcnt(0)" ::: "memory"); SWRITE(0, 0); SLOAD(0, 1); __syncthreads();
    QK(pA0, pA1, K_lds, 0); post(pA0, pA1, 0); expHalf(pA0); expHalf(pA1);
    SWAIT(); SWRITE(1, 0); __syncthreads();
    for (int j = 1; j + 1 < NT; j += 2) {
        SBAR(); QK(pB0, pB1, K_lds + SHM_K, j);
        finishSM(pA0, pA1, l_reg, pa0, pa1, pa2, pa3); SBAR();
        SLOAD(0, j + 1); SBAR();
        post(pB0, pB1, j); PV(0, pB0, pB1);
        __syncthreads(); SWAIT(); SWRITE(0, 0);
        __syncthreads();
        SBAR(); QK(pA0, pA1, K_lds, j + 1);
        finishSM(pB0, pB1, l_reg, pa0, pa1, pa2, pa3); SBAR();
        SLOAD(0, j + 2); SBAR();
        post(pA0, pA1, j + 1); PV(1, pA0, pA1);
        __syncthreads(); SWAIT(); SWRITE(1, 0);
        __syncthreads();
    }
    SBAR(); QK(pB0, pB1, K_lds + SHM_K, NT - 1);
    finishSM(pA0, pA1, l_reg, pa0, pa1, pa2, pa3); SBAR();
    post(pB0, pB1, NT - 1); PV(0, pB0, pB1);
    finishSM(pB0, pB1, l_reg, pa0, pa1, pa2, pa3); SBAR();
    PV(1, pA0, pA1);
    { auto rr = __builtin_amdgcn_permlane32_swap(__float_as_uint(l_reg), __float_as_uint(l_reg), false, false); l_reg = __uint_as_float(rr[0]) + __uint_as_float(rr[1]); }
    if (hi == 0) li_l[r32] = l_reg; asm volatile("s_waitcnt lgkmcnt(0)" ::: "memory");
    float rli[16];
#pragma unroll
    for (int r = 0; r < 16; ++r) rli[r] = __builtin_amdgcn_rcpf(li_l[crow(r, hi)]);
    if (MODE == 0) {
        __syncthreads();
        float* pb = (float*)lds + qb * (32 * 128);
        if (half == 1) {
#pragma unroll
            for (int r = 0; r < 16; ++r)
#pragma unroll
                for (int d0 = 0; d0 < 4; ++d0) pb[crow(r, hi) * 128 + d0 * 32 + r32] = o[d0][r] * rli[r] * A.lam;
        }
        __syncthreads();
        if (half == 0) {
            float ssq[16];
#pragma unroll
            for (int r = 0; r < 16; ++r) { float s = 0.f;
#pragma unroll
                for (int d0 = 0; d0 < 4; ++d0) { const float v = o[d0][r] * rli[r] - pb[crow(r, hi) * 128 + d0 * 32 + r32]; o[d0][r] = v; s += v * v; }
                ssq[r] = s; }
#pragma unroll
            for (int r = 0; r < 16; ++r) { float v = ssq[r]; v = bfly_add<1>(v); v = bfly_add<2>(v); v = bfly_add<4>(v); v = bfly_add<8>(v); v = bfly_add<16>(v); ssq[r] = v; }
            float gv[4];
#pragma unroll
            for (int d0 = 0; d0 < 4; ++d0) gv[d0] = A.subg[d0 * 32 + r32] * A.oscale;
            __hip_bfloat16* Ow = (__hip_bfloat16*)A.Ob + (long)(qb * QBLK) * DM;
#pragma unroll
            for (int r = 0; r < 16; ++r) { const float rn = rsqrtf(ssq[r] * (1.f / 128.f) + EPS); const int orow = crow(r, hi);
#pragma unroll
                for (int d0 = 0; d0 < 4; ++d0) Ow[(long)orow * DM + d0 * 32 + r32] = __float2bfloat16(o[d0][r] * rn * gv[d0]); }
        }
    } else {
        __hip_bfloat16* Ow = (__hip_bfloat16*)A.Ob + (long)(qb * QBLK) * DM + half * 64;
#pragma unroll
        for (int r = 0; r < 16; ++r) { const int orow = crow(r, hi);
#pragma unroll
            for (int d0 = 0; d0 < 2; ++d0) Ow[(long)orow * DM + d0 * 32 + r32] = __float2bfloat16(o[d0][r] * rli[r]); }
    }
    __builtin_amdgcn_s_setprio(0);
    __syncthreads();
#undef TROW
#undef SLOAD
#undef SWRITE
#undef SWAIT
#undef PV
#undef QK
}
#undef KSWZ
#undef SBAR
}

constexpr int LDS_BYTES = 131072 + 1024;
constexpr int OFF_BARST = 131072 + 512;
struct Args { const float* in[27]; float* out; unsigned char* ws; long long pad; };
enum { I_XP = 0, I_XS, I_MEMP, I_MEMS, I_N1G, I_WIN, I_QNA, I_KNA, I_LQ1, I_LK1, I_LQ2, I_LK2, I_SUBG, I_RELB, I_QNB, I_KNB, I_NAB, I_MEMG, I_WMEM, I_QNC, I_KNC, I_WOUT, I_N2G, I_WUP, I_CW, I_CB, I_WDN };

__device__ __forceinline__ void transpose_item(const float* W, int K, int N, bf16_t* WT, int kb, int n0, int src0, LAS float* scr, int lane, const float* gk = nullptr) {
    const int k0 = 64 * kb;
#pragma unroll 8
    for (int i = 0; i < 32; ++i) { const int kk = 2 * i + (lane >> 5); scr[kk * 33 + (lane & 31)] = W[(size_t)(k0 + kk) * N + src0 + (lane & 31)] * (gk ? gk[k0 + kk] : 1.f); }
    asm volatile("s_waitcnt lgkmcnt(0)" ::: "memory");
    const int c = lane & 7;
#pragma unroll
    for (int j = 0; j < 4; ++j) { const int n = (lane >> 3) + 8 * j; const LAS float* s = scr + (8 * c) * 33 + n;
        u32x4 o; o.x = cvtpk(s[0 * 33], s[1 * 33]); o.y = cvtpk(s[2 * 33], s[3 * 33]); o.z = cvtpk(s[4 * 33], s[5 * 33]); o.w = cvtpk(s[6 * 33], s[7 * 33]);
        *(u32x4*)(WT + (size_t)(n0 + n) * K + k0 + 8 * c) = o; }
    asm volatile("s_waitcnt lgkmcnt(0)" ::: "memory");
}
__device__ __forceinline__ int zcol_src(int z) {
    if (z < 1024) { const int base = z < 512 ? 0 : 512, zz = z & 511, h = zz >> 7, s = (zz >> 6) & 1, d = zz & 63; return base + s * 256 + 64 * h + d; }
    return z;
}
__device__ __forceinline__ int ztile_logical(int n0) { const int pn = n0 >> 8, rem = n0 & 255, bj = rem >> 7, wc = (rem >> 5) & 3; return 256 * pn + 64 * wc + 32 * bj; }
__device__ __forceinline__ void rms_row_to_bf16(const float* xrow, const float* g, bf16_t* orow, int lane) {
    const f32x4* xr = (const f32x4*)xrow + lane; const f32x4* gr = (const f32x4*)g + lane;
    f32x4 v[4]; float s = 0.f;
#pragma unroll
    for (int j = 0; j < 4; ++j) { v[j] = xr[64 * j]; s += (v[j][0] * v[j][0] + v[j][1] * v[j][1]) + (v[j][2] * v[j][2] + v[j][3] * v[j][3]); }
    const float rstd = rsqrtf(wave_sum(s) * (1.f / DM) + EPS);
    u32x2* o8 = (u32x2*)orow + lane;
#pragma unroll
    for (int j = 0; j < 4; ++j) { const f32x4 gg = g ? gr[64 * j] : (f32x4){1.f, 1.f, 1.f, 1.f}; u32x2 w; w.x = cvtpk(v[j][0] * rstd * gg[0], v[j][1] * rstd * gg[1]); w.y = cvtpk(v[j][2] * rstd * gg[2], v[j][3] * rstd * gg[3]); o8[64 * j] = w; }
}
__device__ __forceinline__ void rms_row2_to_bf16(const float* xa, const float* xb, const float* g, bf16_t* oa, bf16_t* ob, int lane) {
    const f32x4* ra = (const f32x4*)xa + lane; const f32x4* rb = (const f32x4*)xb + lane; const f32x4* gr = (const f32x4*)g + lane;
    f32x4 va[4], vb[4]; float sa = 0.f, sb = 0.f;
#pragma unroll
    for (int j = 0; j < 4; ++j) { va[j] = ra[64 * j]; vb[j] = rb[64 * j]; }
#pragma unroll
    for (int j = 0; j < 4; ++j) { sa += (va[j][0] * va[j][0] + va[j][1] * va[j][1]) + (va[j][2] * va[j][2] + va[j][3] * va[j][3]); sb += (vb[j][0] * vb[j][0] + vb[j][1] * vb[j][1]) + (vb[j][2] * vb[j][2] + vb[j][3] * vb[j][3]); }
    const float rsa = rsqrtf(wave_sum(sa) * (1.f / DM) + EPS), rsb = rsqrtf(wave_sum(sb) * (1.f / DM) + EPS);
    u32x2* pa = (u32x2*)oa + lane; u32x2* pb = (u32x2*)ob + lane;
#pragma unroll
    for (int j = 0; j < 4; ++j) { const f32x4 gg = g ? gr[64 * j] : (f32x4){1.f, 1.f, 1.f, 1.f}; u32x2 w;
        w.x = cvtpk(va[j][0] * rsa * gg[0], va[j][1] * rsa * gg[1]); w.y = cvtpk(va[j][2] * rsa * gg[2], va[j][3] * rsa * gg[3]); pa[64 * j] = w;
        w.x = cvtpk(vb[j][0] * rsb * gg[0], vb[j][1] * rsb * gg[1]); w.y = cvtpk(vb[j][2] * rsb * gg[2], vb[j][3] * rsb * gg[3]); pb[64 * j] = w; }
}
__device__ __forceinline__ void raw_rows_to_bf16(const float* xa, const float* xb, bf16_t* oa, bf16_t* ob, float* psa, float* psb, int lane, bool two) {
    const f32x4* ra = (const f32x4*)xa + lane; const f32x4* rb = (const f32x4*)xb + lane;
    f32x4 va[4], vb[4]; float sa = 0.f, sb = 0.f;
#pragma unroll
    for (int j = 0; j < 4; ++j) { va[j] = ra[64 * j]; vb[j] = rb[64 * j]; }
#pragma unroll
    for (int j = 0; j < 4; ++j) { sa += (va[j][0] * va[j][0] + va[j][1] * va[j][1]) + (va[j][2] * va[j][2] + va[j][3] * va[j][3]); sb += (vb[j][0] * vb[j][0] + vb[j][1] * vb[j][1]) + (vb[j][2] * vb[j][2] + vb[j][3] * vb[j][3]); }
    sa = wave_sum(sa); sb = wave_sum(sb);
    u32x2* pa = (u32x2*)oa + lane; u32x2* pb = (u32x2*)ob + lane;
#pragma unroll
    for (int j = 0; j < 4; ++j) { u32x2 w; w.x = cvtpk(va[j][0], va[j][1]); w.y = cvtpk(va[j][2], va[j][3]); pa[64 * j] = w;
        if (two) { w.x = cvtpk(vb[j][0], vb[j][1]); w.y = cvtpk(vb[j][2], vb[j][3]); pb[64 * j] = w; } }
    if (lane < 16) { psa[lane] = lane == 0 ? sa : 0.f; if (two) psb[lane] = lane == 0 ? sb : 0.f; }
}
__device__ __forceinline__ int t5_bucket(int rp) {
    const int ret = rp > 0 ? 16 : 0; const int n = rp < 0 ? -rp : rp;
    if (n < 8) return ret + n;
    int v = 8 + (n >= 12) + (n >= 16) + (n >= 23) + (n >= 32) + (n >= 46) + (n >= 64) + (n >= 91);
    return ret + (v > 15 ? 15 : v);
}


typedef unsigned int u32_t;
#define XB_TMO      128
#define XB_XCNT(j)  (256  + 64 * (j))
#define XB_XSUB(j)  (1280 + 64 * (j))
#define XB_XGEN(j)  (2304 + 64 * (j))
#define XB_TOP      3328
#define XB_TOPGEN   3392
#define XCD_BAR_WORDS 3456
#define XB_SPIN_CAP (1u << 22)
__device__ __forceinline__ unsigned xb_ld(unsigned* p)              { return __hip_atomic_load(p, __ATOMIC_RELAXED, __HIP_MEMORY_SCOPE_AGENT); }
__device__ __forceinline__ unsigned xb_add(unsigned* p, unsigned v) { return __hip_atomic_fetch_add(p, v, __ATOMIC_RELAXED, __HIP_MEMORY_SCOPE_AGENT); }
__device__ __forceinline__ unsigned xb_xcc_id() { return (unsigned)__builtin_amdgcn_s_getreg((3 << 11) | 20) & 0xFu; }
#define XB_SPIN(cond, bar) do { unsigned _sp = 0; while (cond) { __builtin_amdgcn_s_sleep(1); \
    if ((++_sp & 255u) == 0u) { if (xb_ld(&(bar)[XB_TMO])) break; if (_sp > XB_SPIN_CAP) { atomicAdd(&(bar)[XB_TMO], 1u); break; } } } } while (0)
struct XcdBarrier { unsigned* bar; unsigned x; volatile LAS unsigned* st; };
__device__ __forceinline__ XcdBarrier xcd_barrier_post(unsigned* bar, volatile LAS unsigned* st, bool t0) {
    XcdBarrier b; b.bar = bar; b.x = xb_xcc_id(); b.st = st;
    if (t0) (void)xb_add(&bar[XB_XCNT(b.x)], 1u);
    return b;
}
__device__ __forceinline__ void xcd_barrier_complete(unsigned* bar, unsigned x, unsigned& nloc, unsigned& nx) {
    const unsigned G = gridDim.x * gridDim.y * gridDim.z;
    unsigned sum, cnt, mine, sp = 0u;
    for (;;) {
        sum = 0u; cnt = 0u; mine = 0u;
#pragma unroll
        for (unsigned j = 0; j < 16; ++j) { const unsigned c = xb_ld(&bar[XB_XCNT(j)]); sum += c; cnt += (c > 0u) ? 1u : 0u; mine = (j == x) ? c : mine; }
        if (sum == G) break;
        __builtin_amdgcn_s_sleep(1);
        if ((++sp & 255u) == 0u) { if (xb_ld(&bar[XB_TMO])) break; if (sp > XB_SPIN_CAP) { atomicAdd(&bar[XB_TMO], 1u); break; } }
    }
    nloc = mine > 0u ? mine : 1u; nx = cnt > 0u ? cnt : 1u;
}
__device__ __forceinline__ void xcd_barrier(const XcdBarrier& b, bool t0) {
    asm volatile("s_waitcnt vmcnt(0)" ::: "memory");
    __syncthreads();
    if (t0) {
        unsigned* bar = b.bar;
        __builtin_amdgcn_s_waitcnt(0);
        unsigned nloc = b.st[0], nx = b.st[1];
        if (nloc == 0u) { xcd_barrier_complete(bar, b.x, nloc, nx); b.st[0] = nloc; b.st[1] = nx; }
        const unsigned old = xb_add(&bar[XB_XSUB(b.x)], 1u);
        const unsigned gen = old / nloc;
        if (old + 1u == (gen + 1u) * nloc) {
            __builtin_amdgcn_fence(__ATOMIC_RELEASE, "agent");
            asm volatile("s_waitcnt vmcnt(0)" ::: "memory");
            const unsigned og = xb_add(&bar[XB_TOP], 1u);
            const unsigned tg = og / nx;
            if (og + 1u == (tg + 1u) * nx) xb_add(&bar[XB_TOPGEN], 1u);
            else XB_SPIN(xb_ld(&bar[XB_TOPGEN]) == tg, bar);
            __builtin_amdgcn_fence(__ATOMIC_ACQUIRE, "agent");
            xb_add(&bar[XB_XGEN(b.x)], 1u);
            asm volatile("s_waitcnt vmcnt(0)" ::: "memory");
        } else {
            XB_SPIN(xb_ld(&bar[XB_XGEN(b.x)]) == gen, bar);
            __builtin_amdgcn_fence(__ATOMIC_ACQUIRE, "agent");
            asm volatile("s_waitcnt vmcnt(0)" ::: "memory");
        }
    }
    __syncthreads();
}

typedef const __attribute__((address_space(4))) struct Args* CArgsP;
#define PHASE_ENV \
    CArgsP ap_ = (CArgsP)__builtin_amdgcn_kernarg_segment_ptr(); asm volatile("" : "+s"(ap_)); \
    unsigned char* ws = ap_->ws; float* out = ap_->out; (void)out; \
    bf16_t* XN = (bf16_t*)(ws + WS_XN); bf16_t* XNM = (bf16_t*)(ws + WS_XNM); bf16_t* Z = (bf16_t*)(ws + WS_Z); bf16_t* MIX = (bf16_t*)(ws + WS_MIX); \
    bf16_t* GB = (bf16_t*)(ws + WS_G); bf16_t* MKV = (bf16_t*)(ws + WS_MKV); float* PS = (float*)(ws + WS_PS); float* GT = (float*)(ws + WS_GT); float* CT = (float*)(ws + WS_CT); \
    (void)XN; (void)XNM; (void)Z; (void)MIX; (void)GB; (void)MKV; (void)PS; (void)GT; (void)CT;

__global__ void __launch_bounds__(NTHREADS, 2) hymba_fwd(Args args) {
    extern __shared__ __attribute__((aligned(16))) unsigned char lds[];
    cg::grid_group grid = cg::this_grid();
    const int tid = threadIdx.x, lane = tid & 63, wave = __builtin_amdgcn_readfirstlane(tid >> 6);
    const int G = gridDim.x, bx = blockIdx.x;
    const int vcu = (G % 8 == 0) ? (bx % 8) * (G / 8) + bx / 8 : bx;
    LAS unsigned char* ldsl = (LAS unsigned char*)lds;
    volatile LAS unsigned* barst = (volatile LAS unsigned*)(ldsl + OFF_BARST);
    if (tid < 2) barst[tid] = 0u;
    __syncthreads();
    { CArgsP ap0 = (CArgsP)__builtin_amdgcn_kernarg_segment_ptr(); (void)xcd_barrier_post((unsigned*)(ap0->ws + WS_BAR), barst, tid == 0); }
#define GRID_BAR() do { CArgsP apb_ = (CArgsP)__builtin_amdgcn_kernarg_segment_ptr(); asm volatile("" : "+s"(apb_)); XcdBarrier b_; b_.bar = (unsigned*)(apb_->ws + WS_BAR); b_.x = xb_xcc_id(); \
        b_.st = (volatile LAS unsigned*)((LAS unsigned char*)lds + OFF_BARST); xcd_barrier(b_, fresh_tid(wave) == 0); } while (0)

    {
        PHASE_ENV
        LAS float* scr = (LAS float*)(ldsl + wave * 16384);
        const int gw = vcu * 8 + wave, NGW = G * 8;
        constexpr int I_IN = 16 * (NZ / 32), I_OUT = 16 * (DM / 32), I_UP = 16 * (NUP / 32), I_DN = (DFF / 64) * (DM / 32), I_MEM = 16 * (512 / 32), I_L = I_IN + I_OUT + I_UP + I_DN + I_MEM;
        for (int it = gw; it < 2 * I_L; it += NGW) {
            const int l = it / I_L; int r = it - l * I_L; unsigned char* wl = ws + l * WS_WL;
            if (r < I_IN) { const int nb = r % (NZ / 32), kb = r / (NZ / 32), n0 = 32 * nb; transpose_item(ap_->in[I_WIN] + (size_t)l * DM * NZ, DM, NZ, (bf16_t*)(wl + WO_IN), kb, n0, zcol_src(ztile_logical(n0)), scr, lane, ap_->in[I_N1G] + l * DM); continue; } r -= I_IN;
            if (r < I_OUT) { const int nb = r % (DM / 32), kb = r / (DM / 32), n0 = 32 * nb; transpose_item(ap_->in[I_WOUT] + (size_t)l * DM * DM, DM, DM, (bf16_t*)(wl + WO_OUT), kb, n0, n0, scr, lane); continue; } r -= I_OUT;
            if (r < I_UP) { const int nb = r % (NUP / 32), kb = r / (NUP / 32), n0 = 32 * nb; const int pn = n0 >> 8, bj = (n0 >> 7) & 1, i0 = n0 & 127;
                transpose_item(ap_->in[I_WUP] + (size_t)l * DM * NUP, DM, NUP, (bf16_t*)(wl + WO_UP), kb, n0, (bj ? DFF : 0) + 128 * pn + i0, scr, lane, ap_->in[I_N2G] + l * DM); continue; } r -= I_UP;
            if (r < I_DN) { const int nb = r % (DM / 32), kb = r / (DM / 32), n0 = 32 * nb; transpose_item(ap_->in[I_WDN] + (size_t)l * DFF * DM, DFF, DM, (bf16_t*)(wl + WO_DN), kb, n0, n0, scr, lane); continue; } r -= I_DN;
            { const int nb = r % (512 / 32), kb = r / (512 / 32), n0 = 32 * nb; transpose_item(ap_->in[I_WMEM] + (size_t)l * DM * 512, DM, 512, (bf16_t*)(wl + WO_MEM), kb, n0, ztile_logical(n0), scr, lane); }
        }
        for (int m = gw; m < MT; m += 2 * NGW) {
            const int m2 = m + NGW;
            const float* xa = m < MP ? ap_->in[I_XP] + (size_t)m * DM : ap_->in[I_XS] + (size_t)(m - MP) * DM;
            const float* xb = m2 < MP ? ap_->in[I_XP] + (size_t)m2 * DM : ap_->in[I_XS] + (size_t)((m2 < MT ? m2 : m) - MP) * DM;
            raw_rows_to_bf16(xa, xb, XN + (size_t)m * DM, XN + (size_t)(m2 < MT ? m2 : m) * DM, PS + (size_t)m * 16, PS + (size_t)(m2 < MT ? m2 : m) * 16, lane, m2 < MT); }
        for (int m = gw; m < 2 * MMEM; m += NGW) { const int l = m / MMEM, r = m - l * MMEM; const float* xr = r < NBATCH * MEMT ? ap_->in[I_MEMP] + (size_t)r * DM : ap_->in[I_MEMS] + (size_t)(r - NBATCH * MEMT) * DM;
            rms_row_to_bf16(xr, ap_->in[I_MEMG] + l * DM, XNM + (size_t)m * DM, lane); }
        for (int i = bx * NTHREADS + tid; i < 2 * DFF; i += G * NTHREADS) { const int l = i / DFF, c = i - l * DFF; const float* w = ap_->in[I_CW] + (size_t)l * 3 * NUP; const float* b = ap_->in[I_CB] + (size_t)l * NUP;
            f32x4 a = {w[c], w[NUP + c], w[2 * NUP + c], b[c]}, g = {w[DFF + c], w[NUP + DFF + c], w[2 * NUP + DFF + c], b[DFF + c]}; *(f32x4*)(CT + (size_t)i * 8) = a; *(f32x4*)(CT + (size_t)i * 8 + 4) = g; }
        if (bx == 0) {
            for (int i = tid; i < 2 * 12 * 64; i += NTHREADS) { const int l = i / 768, t = (i / 64) % 12, d = i & 63; float v = 1.f;
                if (t < 2) v = ap_->in[I_QNA][l * 64 + d] * C2; else if (t < 4) v = ap_->in[I_KNA][l * 64 + d]; else if (t == 6) v = ap_->in[I_QNB][l * 64 + d] * C2; else if (t == 7) v = ap_->in[I_KNB][l * 64 + d];
                else if (t == 9) v = ap_->in[I_QNC][l * 64 + d] * C2; else if (t == 10) v = ap_->in[I_KNC][l * 64 + d];
                GT[i] = v; }
        }
    }
    grid.sync();

#pragma nounroll
    for (int l = 0; l < 2; ++l) {
        {
            PHASE_ENV unsigned char* wl = ws + l * WS_WL;
            pg8::EpiZ E{Z, NZ, GT + l * 768, 0x2CFu, PS};
            pg8::gemm_phase<pg8::EpiZ, false>(ldsl, XN, (const bf16_t*)(wl + WO_IN), DM, MT / 256, NZ / 256, G, bx, wave, E);
            pg8::EpiZ Em{MKV, 512, GT + l * 768 + 640, 0x1u, nullptr};
            pg8::gemm_phase<pg8::EpiZ, false>(ldsl, XNM + (size_t)l * MMEM * DM, (const bf16_t*)(wl + WO_MEM), DM, MMEM / 256, 2, G, bx, wave, Em);
        }
        GRID_BAR();
        {
            PHASE_ENV
            float* lutA = (float*)(lds + att::OFF_LUTA); float* lutB = (float*)(lds + att::OFF_LUTB); float* misc = (float*)(lds + att::OFF_MISC);
            int t2 = fresh_tid(wave); asm volatile("" : "+v"(t2));
            for (int i = t2; i < 4 * 641; i += NTHREADS) { const int h = i / 641, x = i - h * 641; lutA[h * att::LUTA_STRIDE + x] = ap_->in[I_RELB][t5_bucket(x - 320) * 4 + h] * LOG2E; }
            for (int i = t2; i < 4 * 15 * 128; i += NTHREADS) { const int x = i & 127, hd = i >> 7, dc = x - 49; lutB[i] = (dc >= 0 && dc <= 30) ? ap_->in[I_NAB][(size_t)l * 4 * 15 * 31 + hd * 31 + dc] * LOG2E : 0.f; }
            const int lane = t2 & 63;
            if (wave == 0) { const float a = wave_sum(ap_->in[I_LQ1][l * 64 + lane] * ap_->in[I_LK1][l * 64 + lane]), b = wave_sum(ap_->in[I_LQ2][l * 64 + lane] * ap_->in[I_LK2][l * 64 + lane]);
                const float lam_init = 0.8f - 0.6f * expf(-0.3f * (float)l); if (lane == 0) { misc[0] = expf(a) - expf(b) + lam_init; misc[1] = 1.f - lam_init; }
                auto wmax = [&](float v) { return wave_max(fabsf(v)); };
                const float gqa = wmax(ap_->in[I_QNA][l * 64 + lane]), gka = wmax(ap_->in[I_KNA][l * 64 + lane]), gqb = wmax(ap_->in[I_QNB][l * 64 + lane]), gkb = wmax(ap_->in[I_KNB][l * 64 + lane]);
                const float gqc = wmax(ap_->in[I_QNC][l * 64 + lane]), gkc = wmax(ap_->in[I_KNC][l * 64 + lane]);
                const float rbm = wmax(fmaxf(fabsf(ap_->in[I_RELB][lane]), fabsf(ap_->in[I_RELB][64 + lane])));
                float nb = 0.f; for (int i = lane; i < 4 * 15 * 31; i += 64) nb = fmaxf(nb, fabsf(ap_->in[I_NAB][(size_t)l * 4 * 15 * 31 + i])); nb = wmax(nb);
                if (lane == 0) { misc[2] = 1.02f * 64.f * C2 * gqa * gka + rbm * LOG2E; misc[3] = 1.02f * 64.f * C2 * gqb * gkb + nb * LOG2E; misc[4] = 1.02f * 64.f * C2 * gqc * gkc; } }
            __syncthreads();
#define SGPRF(x) __builtin_bit_cast(float, __builtin_amdgcn_readfirstlane(__builtin_bit_cast(int, (float)(x))))
            const float lam = SGPRF(misc[0]), oscale = SGPRF(misc[1]), mshA = SGPRF(misc[2]), mshB = SGPRF(misc[3]), mshC = SGPRF(misc[4]);
            att::UnitArgs U;
            U.subg = ap_->in[I_SUBG] + l * 128; U.lam = lam; U.oscale = oscale; U.tile0 = 0; U.R = 0;
            for (int u = vcu; u < 2560; u += G) {
                int h, qblk, S_; size_t row0;
                if (u < 2048) { const int b = (u & 255) >> 5, c = u & 31, i = u >> 8; h = i >> 1; qblk = (i & 1) * 32 + c; row0 = (size_t)b * SP; S_ = SP; }
                else { const int v = u - 2048, b = (v & 255) >> 5, c = v & 31, idx = (v >> 8) * 32 + c; h = idx >> 4; qblk = idx & 15; row0 = (size_t)MP + (size_t)b * SS; S_ = SS; }
                U.q0 = 128 * qblk; U.h = h; U.NT = S_ / 64; U.ldk = NZ; U.mshift = mshA;
                U.Qb = Z + (row0 + U.q0) * NZ + 128 * h; U.Kb = Z + row0 * NZ + 512 + 128 * h; U.Vb = Z + row0 * NZ + 1024 + 128 * h; U.Ob = MIX + (row0 + U.q0) * DM + 128 * h;
                U.farL = SGPRF(lutA[h * att::LUTA_STRIDE + 0]); U.farR = SGPRF(lutA[h * att::LUTA_STRIDE + 640]);
                att::attn_unit<0>(U, (char*)lds, wave); }
            for (int u = vcu; u < 1280; u += G) {
                int seq, blk, p, R; size_t row0;
                if (u < 1024) { p = u & 1; blk = (u >> 1) & 63; seq = u >> 7; R = SP / GW; row0 = (size_t)seq * SP; }
                else { const int v = u - 1024; p = v & 1; blk = (v >> 1) & 15; seq = v >> 5; R = SS / GW; row0 = (size_t)MP + (size_t)seq * SS; }
                const int r0 = 2 * blk; int lo = r0 - 4; lo = lo < 0 ? 0 : lo; lo = lo > R - 8 ? R - 8 : lo; int hi2 = r0 + 1 - 4; hi2 = hi2 < 0 ? 0 : hi2; hi2 = hi2 > R - 8 ? R - 8 : hi2; hi2 += 7;
                U.q0 = r0; U.h = p; U.tile0 = lo; U.R = R; U.NT = ((hi2 - lo + 1) + 1) & ~1; U.ldk = NZ; U.mshift = mshB;
                U.Qb = Z + (row0 + 128 * blk) * NZ + 1536 + 128 * p; U.Kb = Z + row0 * NZ + 1792 + 128 * p; U.Vb = Z + row0 * NZ + 2048 + 128 * p; U.Ob = MIX + (row0 + 128 * blk) * DM + 512 + 128 * p;
                att::attn_unit<1>(U, (char*)lds, wave); }
            for (int u = vcu; u < 1280; u += G) { const int p = u & 1, blk = u >> 1; const size_t row = (size_t)blk * 128;
                const int mb = row < MP ? (int)(row / SP) : NBATCH + (int)((row - MP) / SS);
                U.NT = MEMT / 64; U.ldk = 512; U.h = p; U.q0 = 0; U.mshift = mshC;
                U.Qb = Z + row * NZ + 2304 + 128 * p; U.Kb = MKV + (size_t)mb * MEMT * 512 + 128 * p; U.Vb = MKV + (size_t)mb * MEMT * 512 + 256 + 128 * p; U.Ob = MIX + row * DM + 768 + 128 * p;
                att::attn_unit<2>(U, (char*)lds, wave); }
        }
        GRID_BAR();
        {
            PHASE_ENV unsigned char* wl = ws + l * WS_WL;
            pg8::EpiRes E{nullptr, nullptr, XN, nullptr, PS};
            pg8::gemm_phase<pg8::EpiRes, false>(ldsl, MIX, (const bf16_t*)(wl + WO_OUT), DM, MT / 256, DM / 256, G, bx, wave, E);
        }
        GRID_BAR();
        {
            PHASE_ENV unsigned char* wl = ws + l * WS_WL;
            pg8::EpiConv E{GB, CT + (size_t)l * DFF * 8, PS};
            pg8::gemm_phase<pg8::EpiConv, true>(ldsl, XN, (const bf16_t*)(wl + WO_UP), DM, NHT, NUP / 256, G, bx, wave, E);
        }
        GRID_BAR();
        {
            PHASE_ENV unsigned char* wl = ws + l * WS_WL;
            pg8::EpiRes E{nullptr, nullptr, XN, l == 1 ? out : nullptr, l == 0 ? PS : nullptr};
            pg8::gemm_phase<pg8::EpiRes, false>(ldsl, GB, (const bf16_t*)(wl + WO_DN), DFF, MT / 256, DM / 256, G, bx, wave, E);
        }
        if (l == 0) GRID_BAR();
    }
}

extern "C" void kernel_launch(void* const* d_in, const int* in_sizes, int n_in, void* d_out, int out_size, void* d_ws, size_t ws_size, hipStream_t stream) {
    static int grid = 0;
    if (grid == 0) {
        if (n_in != 27 || out_size != MT * DM || ws_size < WS_END) { fprintf(stderr, "kernel_launch: unexpected shapes (n_in %d out %d ws %zu)\n", n_in, out_size, ws_size); grid = -1; return; }
        int dev = 0, cus = 0, per_cu = 0;
        hipGetDevice(&dev); hipDeviceGetAttribute(&cus, hipDeviceAttributeMultiprocessorCount, dev);
        if (hipFuncSetAttribute((const void*)hymba_fwd, hipFuncAttributeMaxDynamicSharedMemorySize, LDS_BYTES) != hipSuccess) { fprintf(stderr, "kernel_launch: hipFuncSetAttribute failed\n"); grid = -1; return; }
        if (hipOccupancyMaxActiveBlocksPerMultiprocessor(&per_cu, (const void*)hymba_fwd, NTHREADS, LDS_BYTES) != hipSuccess || per_cu < 1) { fprintf(stderr, "kernel_launch: occupancy query says %d blocks/CU\n", per_cu); per_cu = 1; }
        (void)hipGetLastError();
        grid = cus;
    }
    if (grid < 0) return;
    if (hipMemsetAsync((char*)d_ws + WS_BAR, 0, XCD_BAR_WORDS * 4, stream) != hipSuccess) { fprintf(stderr, "kernel_launch: memset of the barrier words failed\n"); return; }
    Args a{};
    for (int i = 0; i < 27; ++i) a.in[i] = (const float*)d_in[i];
    a.out = (float*)d_out; a.ws = (unsigned char*)d_ws; a.pad = 0;
    void* kargs[] = {&a};
    hipError_t e = hipLaunchCooperativeKernel((const void*)hymba_fwd, dim3(grid), dim3(NTHREADS), kargs, LDS_BYTES, stream);
    if (e != hipSuccess) fprintf(stderr, "kernel_launch: cooperative launch failed: %s (grid %d)\n", hipGetErrorString(e), grid);
}
```
